# Optimizing an MI355X kernel written in HIP

```python
import math
import jax, jax.numpy as jnp
from jax import lax
import numpy as np

D_MODEL = 1024
BATCH = 8
SEQ = 4096
DEPTH = 4

CHUNK = 64
N_MIXERS = 2
S5_GROUP = 16
S5_GROUPS = D_MODEL // S5_GROUP
S5_STATE = 64
S5_DT_MIN = 0.001
S5_DT_MAX = 0.1
S5_LAMBDA_RE_MAX = -1e-4
DA_HEADS = 8
DA_HEAD_DIM = D_MODEL // DA_HEADS // 2
DA_V_DIM = 2 * DA_HEAD_DIM
ROPE_THETA = 10000.0
Q_BLOCK = 128
MAX_POS_OFFSET = 65536
D_FF = 2816
CONV_WIDTH = 3
EPS = 1e-6

N_S5 = (DEPTH + 1) // 2
N_DA = DEPTH // 2

kernel_name = "hybrid_s5_diffattn_convffn_block"


def rms_norm(h, g):
    hf = h.astype(jnp.float32)
    hf = hf * lax.rsqrt(jnp.mean(hf * hf, axis=-1, keepdims=True) + EPS)
    return (hf * g.astype(jnp.float32)).astype(h.dtype)


def modulate(h, shift, scale):
    return h * (1.0 + scale[:, None, :]) + shift[:, None, :]


def rope(t, pos):
    half = t.shape[-1] // 2
    inv = ROPE_THETA ** (-jnp.arange(half, dtype=jnp.float32) / half)
    ang = pos.astype(jnp.float32)[..., None] * inv
    cos = jnp.cos(ang)[:, :, None, :]
    sin = jnp.sin(ang)[:, :, None, :]
    tf = t.astype(jnp.float32)
    t1, t2 = tf[..., :half], tf[..., half:]
    return jnp.concatenate([t1 * cos - t2 * sin, t2 * cos + t1 * sin], axis=-1).astype(t.dtype)


def s5_mixer(u, a_re, a_im, log_dt, b_re, b_im, c_re, c_im, d_skip, w_glu):
    bsz, seq_len, d = u.shape
    f32 = jnp.float32
    lam_re = jnp.minimum(a_re.astype(f32), S5_LAMBDA_RE_MAX)
    lam_im = a_im.astype(f32)
    dt = jnp.exp(log_dt.astype(f32))[:, None]
    dre, dimg = lam_re * dt, lam_im * dt
    mag = jnp.exp(dre)
    lb_re, lb_im = mag * jnp.cos(dimg), mag * jnp.sin(dimg)
    den = lam_re * lam_re + lam_im * lam_im
    nr = lb_re - 1.0
    f_re = (nr * lam_re + lb_im * lam_im) / den
    f_im = (lb_im * lam_re - nr * lam_im) / den
    br, bi = b_re.astype(f32), b_im.astype(f32)
    bb_re = f_re[..., None] * br - f_im[..., None] * bi
    bb_im = f_re[..., None] * bi + f_im[..., None] * br
    cr, ci = c_re.astype(f32), c_im.astype(f32)
    k = jnp.arange(1, CHUNK + 1, dtype=f32)[:, None, None]
    pmag = jnp.exp(k * dre)
    pw_re, pw_im = pmag * jnp.cos(k * dimg), pmag * jnp.sin(k * dimg)

    u32 = u.astype(f32)
    n_chunks = seq_len // CHUNK
    u_c = jnp.moveaxis(u32.reshape(bsz, n_chunks, CHUNK, S5_GROUPS, S5_GROUP), 1, 0)

    def combine(e1, e2):
        a1r, a1i, b1r, b1i = e1
        a2r, a2i, b2r, b2i = e2
        return (a1r * a2r - a1i * a2i, a1r * a2i + a1i * a2r,
                a2r * b1r - a2i * b1i + b2r, a2r * b1i + a2i * b1r + b2i)

    def chunk_step(carry, uc):
        h_re, h_im = carry
        bu_re = jnp.einsum("btgc,gpc->btgp", uc, bb_re)
        bu_im = jnp.einsum("btgc,gpc->btgp", uc, bb_im)
        ar = jnp.broadcast_to(lb_re, bu_re.shape)
        ai = jnp.broadcast_to(lb_im, bu_im.shape)
        _, _, hl_re, hl_im = lax.associative_scan(combine, (ar, ai, bu_re, bu_im), axis=1)
        hp_re, hp_im = h_re[:, None], h_im[:, None]
        ht_re = hl_re + pw_re * hp_re - pw_im * hp_im
        ht_im = hl_im + pw_re * hp_im + pw_im * hp_re
        y = (jnp.einsum("btgp,gcp->btgc", ht_re, cr)
             - jnp.einsum("btgp,gcp->btgc", ht_im, ci))
        return (ht_re[:, -1], ht_im[:, -1]), y

    h0 = jnp.zeros((bsz, S5_GROUPS, S5_STATE), f32)
    _, ys = lax.scan(chunk_step, (h0, h0), u_c)
    y = jnp.moveaxis(ys, 0, 1).reshape(bsz, seq_len, d)
    y = y + d_skip.astype(f32) * u32
    z = jax.nn.gelu(y).astype(u.dtype)
    val, gate = jnp.split(z @ w_glu, 2, axis=-1)
    return val * jax.nn.sigmoid(gate)


def diff_attention(h, pos, w_qkv, w_o, lq1, lk1, lq2, lk2, subln_g, lambda_init):
    bsz, seq_len, d = h.shape
    f32 = jnp.float32
    q, k, v = jnp.split(h @ w_qkv, 3, axis=-1)
    q = rope(q.reshape(bsz, seq_len, 2 * DA_HEADS, DA_HEAD_DIM), pos)
    k = rope(k.reshape(bsz, seq_len, 2 * DA_HEADS, DA_HEAD_DIM), pos)
    q = (q * (DA_HEAD_DIM ** -0.5)).reshape(bsz, seq_len, DA_HEADS, 2, DA_HEAD_DIM)
    k = k.reshape(bsz, seq_len, DA_HEADS, 2, DA_HEAD_DIM)
    v = v.reshape(bsz, seq_len, DA_HEADS, DA_V_DIM)
    lam = (jnp.exp(jnp.sum(lq1.astype(f32) * lk1.astype(f32)))
           - jnp.exp(jnp.sum(lq2.astype(f32) * lk2.astype(f32))) + lambda_init)
    outs = []
    for qb in range(seq_len // Q_BLOCK):
        q0, kend = qb * Q_BLOCK, (qb + 1) * Q_BLOCK
        s = jnp.einsum("bqhcd,bkhcd->bhcqk", q[:, q0:kend], k[:, :kend]).astype(f32)
        q_idx = q0 + jnp.arange(Q_BLOCK)
        chunk_end = (q_idx // CHUNK + 1) * CHUNK
        mask = jnp.arange(kend)[None, :] < chunk_end[:, None]
        p = jax.nn.softmax(jnp.where(mask, s, -jnp.inf), axis=-1)
        attn = (p[:, :, 0] - lam * p[:, :, 1]).astype(v.dtype)
        outs.append(jnp.einsum("bhqk,bkhe->bqhe", attn, v[:, :kend]))
    o = jnp.concatenate(outs, axis=1)
    o = rms_norm(o, subln_g) * (1.0 - lambda_init)
    return o.reshape(bsz, seq_len, d) @ w_o


def conv_ffn(h, w_in, conv_w, conv_b, w_out):
    seq_len = h.shape[1]
    u = h @ w_in
    up = jnp.pad(u, ((0, 0), (CONV_WIDTH - 1, 0), (0, 0)))
    u = conv_b + sum(conv_w[j] * up[:, j:j + seq_len] for j in range(CONV_WIDTH))
    a, b = jnp.split(u, 2, axis=-1)
    return (jax.nn.gelu(a) * b) @ w_out


def setup_inputs(seed: int = 0) -> dict:
    key = jax.random.key(seed)
    ks = jax.random.split(key, 26)
    f32 = jnp.float32

    def nrm(k, shape, s):
        return jax.random.normal(k, shape, f32) * s

    G, P, Cg = S5_GROUPS, S5_STATE, S5_GROUP
    x = nrm(ks[0], (BATCH, SEQ, D_MODEL), 1.0)
    c = nrm(ks[1], (BATCH, D_MODEL), 1.0)
    offset = jax.random.randint(ks[2], (BATCH, 1), 0, MAX_POS_OFFSET, dtype=jnp.int32)
    positions = offset + jnp.arange(SEQ, dtype=jnp.int32)[None, :]
    ada_w = nrm(ks[3], (DEPTH, D_MODEL, 6 * D_MODEL), 0.5 * D_MODEL ** -0.5)
    ada_b = nrm(ks[4], (DEPTH, 6 * D_MODEL), 0.02)
    norm_g = 1.0 + nrm(ks[5], (DEPTH, 4, D_MODEL), 0.05)
    s5_a_re = -0.5 + nrm(ks[6], (N_S5, G, P), 0.01)
    s5_a_im = math.pi * jnp.arange(P, dtype=f32) + nrm(ks[7], (N_S5, G, P), 0.01)
    s5_log_dt = jax.random.uniform(ks[8], (N_S5, G), f32, math.log(S5_DT_MIN), math.log(S5_DT_MAX))
    s5_b_re = nrm(ks[9], (N_S5, G, P, Cg), (2 * Cg) ** -0.5)
    s5_b_im = nrm(ks[10], (N_S5, G, P, Cg), (2 * Cg) ** -0.5)
    s5_c_re = nrm(ks[11], (N_S5, G, Cg, P), P ** -0.5)
    s5_c_im = nrm(ks[12], (N_S5, G, Cg, P), P ** -0.5)
    s5_d = nrm(ks[13], (N_S5, D_MODEL), 1.0)
    s5_w_glu = nrm(ks[14], (N_S5, D_MODEL, 2 * D_MODEL), D_MODEL ** -0.5)
    da_w_qkv = nrm(ks[15], (N_DA, D_MODEL, 3 * D_MODEL), D_MODEL ** -0.5)
    da_w_o = nrm(ks[16], (N_DA, D_MODEL, D_MODEL), D_MODEL ** -0.5)
    da_lq1 = nrm(ks[17], (N_DA, DA_HEAD_DIM), 0.1)
    da_lk1 = nrm(ks[18], (N_DA, DA_HEAD_DIM), 0.1)
    da_lq2 = nrm(ks[19], (N_DA, DA_HEAD_DIM), 0.1)
    da_lk2 = nrm(ks[20], (N_DA, DA_HEAD_DIM), 0.1)
    da_subln_g = 1.0 + nrm(ks[21], (N_DA, DA_V_DIM), 0.05)
    ffn_w_in = nrm(ks[22], (DEPTH, D_MODEL, 2 * D_FF), D_MODEL ** -0.5)
    ffn_conv_w = nrm(ks[23], (DEPTH, CONV_WIDTH, 2 * D_FF), CONV_WIDTH ** -0.5)
    ffn_conv_b = nrm(ks[24], (DEPTH, 2 * D_FF), 0.02)
    ffn_w_out = nrm(ks[25], (DEPTH, D_FF, D_MODEL), D_FF ** -0.5)
    return {"x": x, "c": c, "positions": positions, "ada_w": ada_w, "ada_b": ada_b,
            "norm_g": norm_g, "s5_a_re": s5_a_re, "s5_a_im": s5_a_im, "s5_log_dt": s5_log_dt,
            "s5_b_re": s5_b_re, "s5_b_im": s5_b_im, "s5_c_re": s5_c_re, "s5_c_im": s5_c_im,
            "s5_d": s5_d, "s5_w_glu": s5_w_glu, "da_w_qkv": da_w_qkv, "da_w_o": da_w_o,
            "da_lq1": da_lq1, "da_lk1": da_lk1, "da_lq2": da_lq2, "da_lk2": da_lk2,
            "da_subln_g": da_subln_g, "ffn_w_in": ffn_w_in, "ffn_conv_w": ffn_conv_w,
            "ffn_conv_b": ffn_conv_b, "ffn_w_out": ffn_w_out}


def reference(x, c, positions, ada_w, ada_b, norm_g, s5_a_re, s5_a_im, s5_log_dt,
              s5_b_re, s5_b_im, s5_c_re, s5_c_im, s5_d, s5_w_glu, da_w_qkv, da_w_o,
              da_lq1, da_lk1, da_lq2, da_lk2, da_subln_g, ffn_w_in, ffn_conv_w,
              ffn_conv_b, ffn_w_out):
    cond = jax.nn.silu(c)
    for i in range(DEPTH):
        mod = cond @ ada_w[i] + ada_b[i]
        sh_t, sc_t, g_t, sh_c, sc_c, g_c = jnp.split(mod, 6, axis=-1)
        h = modulate(rms_norm(x, norm_g[i, 0]), sh_t, sc_t)
        j = i // N_MIXERS
        if i % N_MIXERS == 0:
            h = s5_mixer(h, s5_a_re[j], s5_a_im[j], s5_log_dt[j], s5_b_re[j], s5_b_im[j],
                         s5_c_re[j], s5_c_im[j], s5_d[j], s5_w_glu[j])
        else:
            lambda_init = 0.8 - 0.6 * math.exp(-0.3 * i)
            h = diff_attention(h, positions, da_w_qkv[j], da_w_o[j], da_lq1[j], da_lk1[j],
                               da_lq2[j], da_lk2[j], da_subln_g[j], lambda_init)
        x = x + g_t[:, None, :] * rms_norm(h, norm_g[i, 1])
        h = modulate(rms_norm(x, norm_g[i, 2]), sh_c, sc_c)
        h = conv_ffn(h, ffn_w_in[i], ffn_conv_w[i], ffn_conv_b[i], ffn_w_out[i])
        x = x + g_c[:, None, :] * rms_norm(h, norm_g[i, 3])
    return x
```

```cpp
#include <hip/hip_runtime.h>
#include <hip/hip_cooperative_groups.h>
#include <cstdio>
#include <cstdint>
#include <cmath>
namespace cg = cooperative_groups;

#define LAS __attribute__((address_space(3)))
typedef unsigned short bf16_t;
typedef short bf16x8 __attribute__((ext_vector_type(8)));
typedef float f32x4 __attribute__((ext_vector_type(4)));
typedef float f32x2 __attribute__((ext_vector_type(2)));
typedef float f32x16 __attribute__((ext_vector_type(16)));
typedef unsigned u32x4 __attribute__((ext_vector_type(4)));
typedef unsigned u32x2 __attribute__((ext_vector_type(2)));
typedef __bf16 bf16x2_t __attribute__((ext_vector_type(2)));

constexpr int DM = 1024, NB = 8, SEQ = 4096, MTOK = NB * SEQ, DEPTH = 4, DFF = 2816, NFF2 = 2 * DFF;
constexpr float EPS = 1e-6f;
constexpr int NTHR = 512;
constexpr int LDS_BYTES = 147456;

constexpr size_t MiB = 1u << 20;
constexpr size_t WS_MOD = 1 * MiB;
constexpr size_t WS_SCAL = WS_MOD + 800 * 1024;
constexpr size_t WS_A16 = WS_SCAL + 4096;
constexpr size_t WS_CS = 2 * MiB;
constexpr size_t WS_WGLU = 10 * MiB;
constexpr size_t WS_WQKV = 18 * MiB;
constexpr size_t WS_WO = 30 * MiB;
constexpr size_t WS_WIN = 34 * MiB;
constexpr size_t WS_WOUT = 78 * MiB;
constexpr size_t WS_S5W1 = 100 * MiB;
constexpr size_t WS_S5W2 = 116 * MiB;
constexpr size_t WS_XN = 140 * MiB;
constexpr size_t WS_H = 204 * MiB;
constexpr size_t WS_SCR = 268 * MiB;
constexpr size_t WS_END = 492 * MiB;
constexpr size_t SCR_S5A = 0;
constexpr size_t SCR_HL = 96 * MiB;
constexpr size_t SCR_Z = 160 * MiB;
constexpr size_t SCR_Q = 0;
constexpr size_t SCR_K = 64 * MiB;
constexpr size_t SCR_VT = 128 * MiB;
constexpr size_t SCR_G = 0;
constexpr size_t SCR_HALO = 176 * MiB;

struct Args {
    const float* in[26];
    float* out;
    unsigned char* ws;
    double invf[32];
    float lam_init[2];
    int pad[2];
};

#define OPQ_S(x) asm volatile("" : "+s"(x))
__device__ __forceinline__ int opqi(int x) { OPQ_S(x); return x; }
#define DPPF(old, src, ctrl) __int_as_float(__builtin_amdgcn_update_dpp(__float_as_int(old), __float_as_int(src), (ctrl), 0xf, 0xf, false))
__device__ __forceinline__ unsigned pk2(float lo, float hi) { f32x2 v = {lo, hi}; bf16x2_t b = __builtin_convertvector(v, bf16x2_t); return __builtin_bit_cast(unsigned, b); }
__device__ __forceinline__ bf16_t f2bf(float f) { return (bf16_t)(pk2(f, 0.f) & 0xffffu); }
__device__ __forceinline__ float bflo(unsigned u) { return __uint_as_float(u << 16); }
__device__ __forceinline__ float bfhi(unsigned u) { return __uint_as_float(u & 0xffff0000u); }
__device__ __forceinline__ float fast_sigmoid(float x) { return __builtin_amdgcn_rcpf(1.0f + __builtin_amdgcn_exp2f(-1.4426950408889634f * x)); }
__device__ __forceinline__ float gelu_tanh(float y) { const float x2 = 1.5957691216057308f * (y + 0.044715f * y * y * y); return y * fast_sigmoid(x2); }
__device__ __forceinline__ float shfl_l(float v, int src) { return __int_as_float(__builtin_amdgcn_ds_bpermute(src << 2, __float_as_int(v))); }
__device__ __forceinline__ float shflx_l(float v, int mask, int lane) { return shfl_l(v, lane ^ mask); }
__device__ __forceinline__ float wave_sum(float v, int lane) {
#pragma unroll
    for (int o = 1; o < 64; o <<= 1) v += shflx_l(v, o, lane);
    return v;
}
__device__ __forceinline__ void sincos_d(double a, float& s, float& c) {
    const double k = rint(a * 0.15915494309189535);
    double r = fma(-k, 6.283185307179586, a);
    r = fma(-k, 2.4492935982947064e-16, r);
    const float rf = (float)r;
    s = sinf(rf); c = cosf(rf);
}

namespace pg8 {
constexpr int BM = 256, BK = 64, HALF = 128, HTB = HALF * BK * 2, STAGE_BYTES = 8 * HTB, NXCD = 8, WGM = 8;
__host__ __device__ __forceinline__ int lds_byte(int r, int c) { const int st = (r >> 4) * 2 + (c >> 5), rr = r & 15, cc = c & 31, ob = rr * 64 + cc * 2; return st * 1024 + (ob ^ (((ob >> 9) & 1) << 5)); }
__host__ __device__ __forceinline__ void stage_rc(int b, int& R, int& C) { const int st = b / 1024, sb = b % 1024, swz = sb ^ (((sb >> 9) & 1) << 5); R = (st >> 1) * 16 + swz / 64; C = (st & 1) * 32 + (swz % 64) / 2; }
__host__ __device__ __forceinline__ int perm32(int rho) { const int n = rho >> 4, i = rho & 15; return 8 * (i >> 2) + 4 * n + (i & 3); }

struct Unit { int pm, pn; };
struct Gemm { const bf16_t* A; const bf16_t* Bt; int lda, ldb, K; };

struct StaticOrder {
    int nM, nN, nwg, G, c;
    __device__ void init(int M, int N, int G_, int c_) { nM = M / BM; nN = N / BM; nwg = nM * nN; G = G_; c = c_; }
    __device__ bool next(int i, Unit& u) const {
        const long L = (long)i * G + c; if (L >= nwg) return false;
        int wgid = (int)L; { const int q = nwg / NXCD, r = nwg % NXCD, xcd = wgid % NXCD, off = wgid / NXCD; wgid = (xcd < r ? xcd * (q + 1) : r * (q + 1) + (xcd - r) * q) + off; }
        const int nig = WGM * nN, gid = wgid / nig, fm = gid * WGM, gsz = (nM - fm) < WGM ? (nM - fm) : WGM;
        u.pm = fm + ((wgid % nig) % gsz); u.pn = (wgid % nig) / gsz; return true;
    }
};
struct S5Order {
    int G, c;
    __device__ bool next(int i, Unit& u) const { const int L = i * G + c; if (L >= 512) return false; u.pm = L; u.pn = L >> 3; return true; }
};

typedef f32x4 Acc[2][2][4][2];

struct EpiPlain {
    static constexpr bool APERM = false;
    bf16_t* O; int ldc;
    __device__ __forceinline__ void operator()(const Acc& acc, const Unit& u, int wr, int wc, int fr, int fq) const {
        const int row0 = u.pm * BM + wr * 64 + fr, col0 = u.pn * BM + wc * 32 + 8 * fq;
#pragma unroll
        for (int ai = 0; ai < 2; ++ai)
#pragma unroll
            for (int m = 0; m < 4; ++m) { bf16_t* rowp = O + (size_t)(row0 + ai * HALF + m * 16) * ldc + col0;
#pragma unroll
                for (int bj = 0; bj < 2; ++bj) { const f32x4 v0 = acc[ai][bj][m][0], v1 = acc[ai][bj][m][1];
                    u32x4 w; w.x = pk2(v0[0], v0[1]); w.y = pk2(v0[2], v0[3]); w.z = pk2(v1[0], v1[1]); w.w = pk2(v1[2], v1[3]);
                    *(u32x4*)(rowp + bj * HALF) = w; } }
    }
};
struct EpiVt {
    static constexpr bool APERM = false;
    bf16_t* O;
    __device__ __forceinline__ void operator()(const Acc& acc, const Unit& u, int wr, int wc, int fr, int fq) const {
        const int row0 = u.pm * BM + wr * 64 + fr, col0 = u.pn * BM + wc * 32 + 8 * fq;
#pragma unroll
        for (int ai = 0; ai < 2; ++ai)
#pragma unroll
            for (int m = 0; m < 4; ++m) { const int row = row0 + ai * HALF + m * 16, h = row >> 7, e = row & 127;
#pragma unroll
                for (int bj = 0; bj < 2; ++bj) { const int col = col0 + bj * HALF, b = col >> 12, l = col & 4095;
                    const f32x4 v0 = acc[ai][bj][m][0], v1 = acc[ai][bj][m][1];
                    u32x4 w; w.x = pk2(v0[0], v0[1]); w.y = pk2(v0[2], v0[3]); w.z = pk2(v1[0], v1[1]); w.w = pk2(v1[2], v1[3]);
                    *(u32x4*)(O + ((size_t)(((b * 8 + h) * 64 + (l >> 6)) * 128 + e)) * 64 + (l & 63)) = w; } }
    }
};
struct EpiHL {
    static constexpr bool APERM = false;
    float* HL;
    __device__ __forceinline__ void operator()(const Acc& acc, const Unit& u, int wr, int wc, int fr, int fq) const {
        const int row0 = u.pm * BM + wr * 64 + fr, col0 = wc * 32 + 8 * fq;
#pragma unroll
        for (int ai = 0; ai < 2; ++ai)
#pragma unroll
            for (int m = 0; m < 4; ++m) { float* rowp = HL + (size_t)(row0 + ai * HALF + m * 16) * 128 + col0;
                *(f32x4*)(rowp) = acc[ai][0][m][0]; *(f32x4*)(rowp + 4) = acc[ai][0][m][1]; }
    }
};
struct EpiS5Y {
    static constexpr bool APERM = false;
    const bf16_t* A; bf16_t* Z; const float* dskip;
    __device__ __forceinline__ void operator()(const Acc& acc, const Unit& u, int wr, int wc, int fr, int fq) const {
        const int g = u.pn;
        const int row0 = u.pm * BM + wr * 64 + fr;
        const int d0 = 16 * g + 8 * (fq & 1);
#pragma unroll
        for (int ai = 0; ai < 2; ++ai)
#pragma unroll
            for (int m = 0; m < 4; ++m) {
                const int R = row0 + ai * HALF + m * 16;
#pragma unroll
                for (int bj = 0; bj < 2; ++bj) {
                    const int n0 = 128 * bj + 32 * wc + 8 * fq, t = n0 >> 4;
                    int Ro = R; asm volatile("" : "+v"(Ro));
                    const u32x4 uu = *(const u32x4*)((const char*)A + (unsigned)((Ro * 384 + n0) * 2));
                    const f32x4 ds0 = *(const f32x4*)(dskip + d0), ds1 = *(const f32x4*)(dskip + d0 + 4);
                    const f32x4 v0 = acc[ai][bj][m][0], v1 = acc[ai][bj][m][1];
                    u32x4 w;
                    w.x = pk2(gelu_tanh(v0[0] + ds0[0] * bflo(uu.x)), gelu_tanh(v0[1] + ds0[1] * bfhi(uu.x)));
                    w.y = pk2(gelu_tanh(v0[2] + ds0[2] * bflo(uu.y)), gelu_tanh(v0[3] + ds0[3] * bfhi(uu.y)));
                    w.z = pk2(gelu_tanh(v1[0] + ds1[0] * bflo(uu.z)), gelu_tanh(v1[1] + ds1[1] * bfhi(uu.z)));
                    w.w = pk2(gelu_tanh(v1[2] + ds1[2] * bflo(uu.w)), gelu_tanh(v1[3] + ds1[3] * bfhi(uu.w)));
                    const int mp = Ro - g * 2048, b = mp >> 8, k = mp & 255;
                    const unsigned tok = (unsigned)(b * SEQ + 16 * k + t);
                    *(u32x4*)((char*)Z + (tok * (unsigned)DM + (unsigned)d0) * 2u) = w;
                    asm volatile("" ::: "memory");
                }
            }
    }
};
struct EpiGLU {
    static constexpr bool APERM = false;
    bf16_t* H;
    __device__ __forceinline__ void operator()(const Acc& acc, const Unit& u, int wr, int wc, int fr, int fq) const {
        const int row0 = u.pm * BM + wr * 64 + fr, col0 = u.pn * HALF + wc * 32 + 8 * fq;
#pragma unroll
        for (int ai = 0; ai < 2; ++ai)
#pragma unroll
            for (int m = 0; m < 4; ++m) {
                float o[8];
#pragma unroll
                for (int n = 0; n < 2; ++n)
#pragma unroll
                    for (int i = 0; i < 4; ++i) o[4 * n + i] = acc[ai][0][m][n][i] * fast_sigmoid(acc[ai][1][m][n][i]);
                u32x4 w; w.x = pk2(o[0], o[1]); w.y = pk2(o[2], o[3]); w.z = pk2(o[4], o[5]); w.w = pk2(o[6], o[7]);
                *(u32x4*)(H + (size_t)(row0 + ai * HALF + m * 16) * DM + col0) = w;
            }
    }
};
struct EpiQK {
    static constexpr bool APERM = false;
    bf16_t* Q; bf16_t* Kb; const float* cs; float qscale;
    __device__ __forceinline__ void operator()(const Acc& acc, const Unit& u, int wr, int wc, int fr, int fq) const {
        const bool isq = u.pn < 4;
        bf16_t* dst = isq ? Q : Kb; const int colbase = (isq ? u.pn : u.pn - 4) * BM; const float sc = isq ? qscale : 1.0f;
        const int row0 = u.pm * BM + wr * 64 + fr;
        const int q8 = 4 * (wc & 1) + fq;
#pragma unroll
        for (int ai = 0; ai < 2; ++ai)
#pragma unroll
            for (int m = 0; m < 4; ++m) {
                const int R = row0 + ai * HALF + m * 16;
                const f32x4 cs0 = *(const f32x4*)(cs + (size_t)R * 64 + 8 * q8), cs1 = *(const f32x4*)(cs + (size_t)R * 64 + 8 * q8 + 4);
                const float cc[4] = {cs0[0], cs0[2], cs1[0], cs1[2]}, ss[4] = {cs0[1], cs0[3], cs1[1], cs1[3]};
#pragma unroll
                for (int bj = 0; bj < 2; ++bj) {
                    const f32x4 lo = acc[ai][bj][m][0], hi = acc[ai][bj][m][1];
                    float ol[4], oh[4];
#pragma unroll
                    for (int i = 0; i < 4; ++i) { ol[i] = (lo[i] * cc[i] - hi[i] * ss[i]) * sc; oh[i] = (hi[i] * cc[i] + lo[i] * ss[i]) * sc; }
                    u32x4 w; w.x = pk2(ol[0], ol[1]); w.y = pk2(ol[2], ol[3]); w.z = pk2(oh[0], oh[1]); w.w = pk2(oh[2], oh[3]);
                    const int col = colbase + 128 * bj + 32 * wc + 8 * fq;
                    if (isq) *(u32x4*)(dst + (size_t)R * DM + col) = w;
                    else { const int b = R >> 12, l = R & 4095, kv = l & 63, slot = (kv & ~12) | ((kv & 4) << 1) | ((kv & 8) >> 1);
                        *(u32x4*)(dst + ((size_t)(((b * 16 + (col >> 6)) * 64 + (l >> 6)) * 64 + slot)) * 64 + (col & 63)) = w; }
                }
                asm volatile("" ::: "memory");
            }
    }
};
__device__ __forceinline__ f32x4 dpp_shr1_4(f32x4 v) { f32x4 r;
#pragma unroll
    for (int i = 0; i < 4; ++i) r[i] = __int_as_float(__builtin_amdgcn_update_dpp(0, __float_as_int(v[i]), 0x111, 0xf, 0xf, true));
    return r; }
__device__ __forceinline__ f32x4 gelu4(f32x4 y) {
    const f32x4 t = y * ((y * y) * (-0.10294324f) + (-2.30220819f));
    f32x4 r;
#pragma unroll
    for (int i = 0; i < 4; ++i) r[i] = __builtin_amdgcn_exp2f(t[i]);
    r = r + 1.0f;
#pragma unroll
    for (int i = 0; i < 4; ++i) r[i] = __builtin_amdgcn_rcpf(r[i]);
    return y * r;
}
struct EpiWin {
    static constexpr bool APERM = true;
    bf16_t* Gout; float* halo; const float* cw; const float* cb;
    __device__ __forceinline__ void operator()(const Acc& acc, const Unit& u, int wr, int wc, int fr, int fq) const {
        const int row0 = u.pm * BM + wr * 64 + 4 * fr;
#pragma unroll
        for (int n = 0; n < 2; ++n) {
            const int ca = u.pn * HALF + wc * 32 + 8 * fq + 4 * n, cbc = DFF + ca;
            const f32x4 w0a = *(const f32x4*)(cw + ca), w1a = *(const f32x4*)(cw + NFF2 + ca), w2a = *(const f32x4*)(cw + 2 * NFF2 + ca), ba = *(const f32x4*)(cb + ca);
            const f32x4 w0b = *(const f32x4*)(cw + cbc), w1b = *(const f32x4*)(cw + NFF2 + cbc), w2b = *(const f32x4*)(cw + 2 * NFF2 + cbc), bb = *(const f32x4*)(cb + cbc);
#pragma unroll
            for (int ai = 0; ai < 2; ++ai) {
                const int strip = (u.pm * BM + ai * HALF + wr * 64) >> 6;
                const f32x4 a0 = acc[ai][0][0][n], a1 = acc[ai][0][1][n], a2 = acc[ai][0][2][n], a3 = acc[ai][0][3][n];
                const f32x4 b0 = acc[ai][1][0][n], b1 = acc[ai][1][1][n], b2 = acc[ai][1][2][n], b3 = acc[ai][1][3][n];
                const f32x4 sa3 = dpp_shr1_4(a3), sa2 = dpp_shr1_4(a2), sb3 = dpp_shr1_4(b3), sb2 = dpp_shr1_4(b2);
                f32x4 o[4];
                o[3] = gelu4(ba + w2a * a3 + w1a * a2 + w0a * a1) * (bb + w2b * b3 + w1b * b2 + w0b * b1);
                o[2] = gelu4(ba + w2a * a2 + w1a * a1 + w0a * a0) * (bb + w2b * b2 + w1b * b1 + w0b * b0);
                o[1] = gelu4(ba + w2a * a1 + w1a * a0 + w0a * sa3) * (bb + w2b * b1 + w1b * b0 + w0b * sb3);
                o[0] = gelu4(ba + w2a * a0 + w1a * sa3 + w0a * sa2) * (bb + w2b * b0 + w1b * sb3 + w0b * sb2);
                bf16_t* gp = Gout + (size_t)(row0 + ai * HALF) * DFF + ca;
#pragma unroll
                for (int m = 0; m < 4; ++m) {
                    if (!(fr == 0 && m < 2)) { u32x2 w; w.x = pk2(o[m][0], o[m][1]); w.y = pk2(o[m][2], o[m][3]); *(u32x2*)(gp + (size_t)m * DFF) = w; }
                }
                if (fr == 0) { float* hp = halo + (size_t)strip * 4 * NFF2; *(f32x4*)(hp + ca) = a0; *(f32x4*)(hp + cbc) = b0; *(f32x4*)(hp + NFF2 + ca) = a1; *(f32x4*)(hp + NFF2 + cbc) = b1; }
                if (fr == 15) { float* hp = halo + ((size_t)strip * 4 + 2) * NFF2; *(f32x4*)(hp + ca) = a2; *(f32x4*)(hp + cbc) = b2; *(f32x4*)(hp + NFF2 + ca) = a3; *(f32x4*)(hp + NFF2 + cbc) = b3; }
                asm volatile("" ::: "memory");
            }
        }
    }
};

template <class Epi, class Sched>
__device__ __forceinline__ void gemm_phase(LAS unsigned char* lds, const Gemm g, const Sched& S, const Epi& E) {
    int tid = threadIdx.x; asm volatile("" : "+v"(tid));
    const int wid = __builtin_amdgcn_readfirstlane(tid >> 6), lane = tid & 63, wr = wid >> 2, wc = wid & 3, fr = lane & 15, fq = lane >> 4;
    const int K = g.K, nt = K / BK;
    unsigned voffA[2], voffB[2];
#pragma unroll
    for (int i = 0; i < 2; ++i) { int R, C; stage_rc(tid * 16 + i * 8192, R, C); const int Rb = (R & ~31) + perm32(R & 31);
        const int Ra = Epi::APERM ? ((R & ~63) + 4 * (R & 15) + ((R >> 4) & 3)) : R;
        voffA[i] = (unsigned)(Ra * g.lda + C) * 2u; voffB[i] = (unsigned)(Rb * g.ldb + C) * 2u; }
    const size_t kstep = (size_t)(BK * 2);
    const size_t hstepA = (size_t)HALF * g.lda * 2, hstepB = (size_t)HALF * g.ldb * 2;
    const size_t tstepA = 2 * hstepA, tstepB = 2 * hstepB;
    const unsigned ldsw = (unsigned)wid * 1024u;
    const int aoff = lds_byte(wr * 64 + fr, fq * 8), boff = lds_byte(wc * 32 + fr, fq * 8);
#define PG8_SA(b, h) (((b) * 2 + (h)) * HTB)
#define PG8_SB(b, h) ((4 + (b) * 2 + (h)) * HTB)
#define PG8_STAGE(bufoff, gbase, voff) do { _Pragma("unroll") for (int _i = 0; _i < 2; ++_i) \
        __builtin_amdgcn_global_load_lds((const unsigned*)((const char*)(gbase) + (voff)[_i]), (LAS unsigned*)(lds + (bufoff) + ldsw + _i * 8192), 16, 0, 0); } while (0)
#define PG8_LDA(dst, b, h) do { _Pragma("unroll") for (int m = 0; m < 4; ++m) _Pragma("unroll") for (int k = 0; k < 2; ++k) dst[m][k] = *(const LAS bf16x8*)(lds + PG8_SA(b, h) + aoff + m * 2048 + k * 1024); } while (0)
#define PG8_LDB(dst, b, h) do { _Pragma("unroll") for (int n = 0; n < 2; ++n) _Pragma("unroll") for (int k = 0; k < 2; ++k) dst[n][k] = *(const LAS bf16x8*)(lds + PG8_SB(b, h) + boff + n * 2048 + k * 1024); } while (0)
#define PG8_MMA(ai, bj, At, Bt) do { __builtin_amdgcn_s_setprio(1); _Pragma("unroll") for (int m = 0; m < 4; ++m) _Pragma("unroll") for (int n = 0; n < 2; ++n) _Pragma("unroll") for (int k = 0; k < 2; ++k) \
        acc[ai][bj][m][n] = __builtin_amdgcn_mfma_f32_16x16x32_bf16(Bt[n][k], At[m][k], acc[ai][bj][m][n], 0, 0, 0); __builtin_amdgcn_s_setprio(0); } while (0)
#define PG8_WAIT_V(n) asm volatile("s_waitcnt vmcnt(" #n ")" ::: "memory")
#define PG8_WAIT_L(n) asm volatile("s_waitcnt lgkmcnt(" #n ")" ::: "memory")
#define PG8_BAR __builtin_amdgcn_s_barrier()
#define PG8_SCHED __builtin_amdgcn_sched_barrier(0)
    Unit cur, nxt; int ui = 0;
    if (!S.next(0, cur)) return;
    Acc acc;
#pragma unroll
    for (int a = 0; a < 2; ++a)
#pragma unroll
        for (int b = 0; b < 2; ++b)
#pragma unroll
            for (int m = 0; m < 4; ++m)
#pragma unroll
                for (int n = 0; n < 2; ++n) acc[a][b][m][n] = (f32x4){0.f, 0.f, 0.f, 0.f};
    bf16x8 At[4][2], B0[2][2], B1[2][2];
    const char* cA = (const char*)g.A + (size_t)cur.pm * tstepA; const char* cB = (const char*)g.Bt + (size_t)cur.pn * tstepB;
    PG8_STAGE(PG8_SB(0, 0), cB, voffB); PG8_STAGE(PG8_SB(0, 1), cB + hstepB, voffB); PG8_STAGE(PG8_SA(0, 0), cA, voffA); PG8_STAGE(PG8_SA(0, 1), cA + hstepA, voffA);
    if (wr == 1) PG8_BAR;
    PG8_WAIT_V(2); PG8_BAR;
    PG8_STAGE(PG8_SB(1, 0), cB + kstep, voffB); PG8_STAGE(PG8_SA(1, 0), cA + kstep, voffA); PG8_STAGE(PG8_SB(1, 1), cB + hstepB + kstep, voffB);
    PG8_WAIT_V(6); PG8_BAR;
    for (;;) {
        const bool has_next = S.next(ui + 1, nxt);
        const char* nA = has_next ? (const char*)g.A + (size_t)nxt.pm * tstepA : cA; const char* nB = has_next ? (const char*)g.Bt + (size_t)nxt.pn * tstepB : cB;
#pragma unroll 1
        for (int t = 0; t < nt; t += 2) {
            const bool last = (t == nt - 2);
            const char* a1 = cA + (size_t)(t + 1) * kstep;
            const char* a2 = last ? nA : cA + (size_t)(t + 2) * kstep; const char* b2 = last ? nB : cB + (size_t)(t + 2) * kstep;
            const char* a3 = a2 + kstep; const char* b3 = b2 + kstep;
            PG8_LDB(B0, 0, 0); PG8_LDB(B1, 0, 1); PG8_SCHED; PG8_LDA(At, 0, 0); PG8_STAGE(PG8_SA(1, 1), a1 + hstepA, voffA);
            PG8_WAIT_V(8); PG8_WAIT_L(0); PG8_BAR; PG8_MMA(0, 0, At, B0); PG8_MMA(0, 1, At, B1); PG8_BAR; PG8_SCHED;
            PG8_LDA(At, 0, 1); PG8_STAGE(PG8_SB(0, 0), b2, voffB); PG8_STAGE(PG8_SB(0, 1), b2 + hstepB, voffB); PG8_STAGE(PG8_SA(0, 0), a2, voffA);
            PG8_WAIT_V(8); PG8_WAIT_L(0); PG8_BAR; PG8_MMA(1, 0, At, B0); PG8_MMA(1, 1, At, B1); PG8_BAR; PG8_SCHED;
            PG8_LDB(B0, 1, 0); PG8_LDB(B1, 1, 1); PG8_SCHED; PG8_LDA(At, 1, 0); PG8_STAGE(PG8_SA(0, 1), a2 + hstepA, voffA);
            PG8_WAIT_V(8); PG8_WAIT_L(0); PG8_BAR; PG8_MMA(0, 0, At, B0); PG8_MMA(0, 1, At, B1); PG8_BAR; PG8_SCHED;
            PG8_LDA(At, 1, 1); PG8_STAGE(PG8_SB(1, 0), b3, voffB); PG8_STAGE(PG8_SB(1, 1), b3 + hstepB, voffB); PG8_STAGE(PG8_SA(1, 0), a3, voffA);
            PG8_WAIT_V(8); PG8_WAIT_L(0); PG8_BAR; PG8_MMA(1, 0, At, B0); PG8_MMA(1, 1, At, B1); PG8_BAR; PG8_SCHED;
        }
        if (wr == 0) PG8_BAR;
        E(acc, cur, wr, wc, fr, fq);
        if (!has_next) break;
#pragma unroll
        for (int a = 0; a < 2; ++a)
#pragma unroll
            for (int b = 0; b < 2; ++b)
#pragma unroll
                for (int m = 0; m < 4; ++m)
#pragma unroll
                    for (int n = 0; n < 2; ++n) acc[a][b][m][n] = (f32x4){0.f, 0.f, 0.f, 0.f};
        cur = nxt; cA = nA; cB = nB; ++ui;
        if (wr == 1) PG8_BAR;
    }
    PG8_WAIT_V(0);
    PG8_BAR;
#undef PG8_SA
#undef PG8_SB
#undef PG8_STAGE
#undef PG8_LDA
#undef PG8_LDB
#undef PG8_MMA
#undef PG8_WAIT_V
#undef PG8_WAIT_L
#undef PG8_BAR
#undef PG8_SCHED
}
}

#define MFMA32(a, b, c) __builtin_amdgcn_mfma_f32_32x32x16_bf16((a), (b), (c), 0, 0, 0)
__device__ __forceinline__ int crow(int r, int hi) { return (r & 3) + 8 * (r >> 2) + 4 * hi; }
constexpr int ATT_KS = 16384;
constexpr int ATT_VS = 16384;
constexpr int ATT_V0 = 3 * ATT_KS;
__device__ __forceinline__ void glds16(const void* sbase, unsigned voff, unsigned lds_dst) { unsigned keep;
    asm volatile("s_mov_b32 %0, m0\n\ts_mov_b32 m0, %3\n\ts_nop 0\n\tglobal_load_lds_dwordx4 %1, %2\n\ts_mov_b32 m0, %0" : "=&s"(keep) : "v"(voff), "s"(sbase), "s"(lds_dst) : "memory"); }

__device__ __forceinline__ void attn_phase(LAS unsigned char* lds, const bf16_t* Q, const bf16_t* Kb, const bf16_t* Vt, bf16_t* O,
                                           const float* subg, float lam, float oscale, int G, int vcu) {
    int tid = threadIdx.x; asm volatile("" : "+v"(tid));
    const int lane = tid & 63, wid = __builtin_amdgcn_readfirstlane(tid >> 6);
    const int r32 = lane & 31, hi = lane >> 5, comp = wid >> 2, wq = wid & 3;
    const unsigned lds0 = (unsigned)(uintptr_t)lds;
    OPQ_S(vcu); OPQ_S(G);
    const int drow = 8 * wid + (lane >> 3);
    const unsigned dsrc = (unsigned)(drow * 128 + (((lane & 7) ^ ((drow >> 1) & 7)) * 16));
    int foff[4];
#pragma unroll
    for (int x = 0; x < 4; ++x) foff[x] = r32 * 128 + (((2 * x + hi) ^ ((r32 >> 1) & 7)) * 16);
    for (int it = vcu * 2; it < 2048; it += ((it & 1) ? 2 * G - 1 : 1)) {
        const int su = it >> 1, half = it & 1;
        const int rr = su >> 8, v = su & 255, xcd = v >> 5, loc = v & 31, grp = loc >> 4, j16 = loc & 15;
        const int bh = xcd * 8 + rr * 2 + grp;
        const int qb = half ? j16 : 31 - j16;
        const int b = bh >> 3, h = bh & 7;
        const size_t rowbase = (size_t)b * SEQ; const int q0 = qb * 128;
        bf16x8 qr[4];
        { const bf16_t* qp = Q + (rowbase + q0 + 32 * wq + r32) * DM + (2 * h + comp) * 64 + hi * 8;
#pragma unroll
          for (int d0 = 0; d0 < 4; ++d0) qr[d0] = *(const bf16x8*)(qp + d0 * 16); }
        const int NT = 2 * qb + 2, myNT = (wq < 2) ? NT - 1 : NT;
        const char* kg = (const char*)(Kb + (size_t)((b * 16 + 2 * h) * 64) * 4096);
        const char* vg = (const char*)(Vt + (size_t)((b * 8 + h) * 64) * 8192);
        const unsigned kdst = lds0 + (unsigned)wid * 1024u, vdst = lds0 + ATT_V0 + (unsigned)wid * 1024u;
#define ATT_DMA(t, ks, vs) do { const char* kp_ = kg + (size_t)(t) * 8192; const char* vp_ = vg + (size_t)(t) * 16384; \
        glds16(kp_, dsrc, (unsigned)__builtin_amdgcn_readfirstlane(kdst + (ks) * ATT_KS)); glds16(kp_ + 64 * 8192, dsrc, (unsigned)__builtin_amdgcn_readfirstlane(kdst + (ks) * ATT_KS + 8192)); \
        glds16(vp_, dsrc, (unsigned)__builtin_amdgcn_readfirstlane(vdst + (vs) * ATT_VS)); glds16(vp_ + 8192, dsrc, (unsigned)__builtin_amdgcn_readfirstlane(vdst + (vs) * ATT_VS + 8192)); } while (0)
#define WAITV(n) asm volatile("s_waitcnt vmcnt(" #n ")" ::: "memory")
#define ATT_BAR() do { asm volatile("s_waitcnt lgkmcnt(0)" ::: "memory"); __builtin_amdgcn_s_barrier(); asm volatile("" ::: "memory"); } while (0)
#define SB() __builtin_amdgcn_sched_barrier(0)
#define KFRAG(dst, kb_, d0) do { dst[0] = *(const LAS bf16x8*)((kb_) + foff[d0]); dst[1] = *(const LAS bf16x8*)((kb_) + 4096 + foff[d0]); } while (0)
#define VFRAG2(dst, vb_, d0, kh) do { dst[0] = *(const LAS bf16x8*)((vb_) + (d0) * 4096 + foff[2 * (kh)]); dst[1] = *(const LAS bf16x8*)((vb_) + (d0) * 4096 + foff[2 * (kh) + 1]); } while (0)
#define EXPPACK(C, B, dst) do { float e_[8]; _Pragma("unroll") for (int j_ = 0; j_ < 8; ++j_) e_[j_] = __builtin_amdgcn_exp2f(C[(B) + j_]); \
        u32x4 w_; w_.x = pk2(e_[0], e_[1]); w_.y = pk2(e_[2], e_[3]); w_.z = pk2(e_[4], e_[5]); w_.w = pk2(e_[6], e_[7]); dst = __builtin_bit_cast(bf16x8, w_); } while (0)
#define PINV(x) asm volatile("" : "+v"(x))
#define MAX3(a, b, c) ({ float mx3_; asm("v_max3_f32 %0, %1, %2, %3" : "=v"(mx3_) : "v"(a), "v"(b), "v"(c)); mx3_; })
#define ROWMAX32(c0, c1) ({ float a_ = MAX3(c0[0], c0[1], c1[0]), b_ = MAX3(c0[2], c0[3], c1[1]); a_ = MAX3(a_, c1[2], c1[3]); \
        _Pragma("unroll") for (int r_ = 4; r_ < 16; r_ += 4) { a_ = MAX3(a_, c0[r_], c0[r_ + 1]); b_ = MAX3(b_, c0[r_ + 2], c0[r_ + 3]); a_ = MAX3(a_, c1[r_], c1[r_ + 1]); b_ = MAX3(b_, c1[r_ + 2], c1[r_ + 3]); } \
        MAX3(a_, b_, b_); })
        f32x16 o[4], negm, lacc;
        const f32x16 zero16 = {0.f, 0.f, 0.f, 0.f, 0.f, 0.f, 0.f, 0.f, 0.f, 0.f, 0.f, 0.f, 0.f, 0.f, 0.f, 0.f};
        const bf16x8 ones8 = {(short)0x3F80, (short)0x3F80, (short)0x3F80, (short)0x3F80, (short)0x3F80, (short)0x3F80, (short)0x3F80, (short)0x3F80};
#pragma unroll
        for (int d0 = 0; d0 < 4; ++d0) o[d0] = zero16;
        lacc = zero16;
        bf16x8 pa[4];
        const LAS unsigned char* kbase = lds + comp * 8192;
        const LAS unsigned char* vbase = lds + ATT_V0;
        ATT_DMA(0, 0, 0);
        ATT_DMA(1, 1, 1);
        if (NT > 2) { ATT_DMA(2, 2, 2); WAITV(8); } else { WAITV(4); }
        ATT_BAR();
        {
            f32x16 c0, c1;
#pragma unroll
            for (int d0 = 0; d0 < 4; ++d0) { bf16x8 kf[2]; KFRAG(kf, kbase, d0);
                if (d0 == 0) { c0 = MFMA32(kf[0], qr[0], zero16); c1 = MFMA32(kf[1], qr[0], zero16); } else { c0 = MFMA32(kf[0], qr[d0], c0); c1 = MFMA32(kf[1], qr[d0], c1); } }
            float mx = ROWMAX32(c0, c1);
            mx = fmaxf(mx, shflx_l(mx, 32, lane));
#pragma unroll
            for (int r = 0; r < 16; ++r) { c0[r] -= mx; c1[r] -= mx; negm[r] = -mx; }
            asm volatile("" : "+v"(negm));
            EXPPACK(c0, 0, pa[0]); EXPPACK(c0, 8, pa[1]); EXPPACK(c1, 0, pa[2]); EXPPACK(c1, 8, pa[3]);
        }
        if (NT > 2) { WAITV(4); } else { WAITV(0); }
        ATT_BAR();
#define ATT_STEP(kb, vb, pa, pn) do { \
            f32x16 c0, c1; bf16x8 kfa[2], kfb[2], vfa[2], vfb[2]; \
            SB(); \
            KFRAG(kfa, kb, 0); KFRAG(kfb, kb, 1); \
            c0 = MFMA32(kfa[0], qr[0], negm); c1 = MFMA32(kfa[1], qr[0], negm); \
            KFRAG(kfa, kb, 2); \
            c0 = MFMA32(kfb[0], qr[1], c0); c1 = MFMA32(kfb[1], qr[1], c1); \
            KFRAG(kfb, kb, 3); \
            c0 = MFMA32(kfa[0], qr[2], c0); c1 = MFMA32(kfa[1], qr[2], c1); \
            VFRAG2(vfa, vb, 0, 0); \
            c0 = MFMA32(kfb[0], qr[3], c0); c1 = MFMA32(kfb[1], qr[3], c1); \
            VFRAG2(vfb, vb, 0, 1); \
            SB(); \
            o[0] = MFMA32(pa[0], vfa[0], o[0]); o[0] = MFMA32(pa[1], vfa[1], o[0]); VFRAG2(vfa, vb, 1, 0); SB(); \
            o[0] = MFMA32(pa[2], vfb[0], o[0]); o[0] = MFMA32(pa[3], vfb[1], o[0]); VFRAG2(vfb, vb, 1, 1); EXPPACK(c0, 0, pn[0]); PINV(pn[0]); SB(); \
            o[1] = MFMA32(pa[0], vfa[0], o[1]); o[1] = MFMA32(pa[1], vfa[1], o[1]); VFRAG2(vfa, vb, 2, 0); SB(); \
            o[1] = MFMA32(pa[2], vfb[0], o[1]); o[1] = MFMA32(pa[3], vfb[1], o[1]); VFRAG2(vfb, vb, 2, 1); EXPPACK(c0, 8, pn[1]); PINV(pn[1]); SB(); \
            o[2] = MFMA32(pa[0], vfa[0], o[2]); o[2] = MFMA32(pa[1], vfa[1], o[2]); VFRAG2(vfa, vb, 3, 0); SB(); \
            o[2] = MFMA32(pa[2], vfb[0], o[2]); o[2] = MFMA32(pa[3], vfb[1], o[2]); VFRAG2(vfb, vb, 3, 1); EXPPACK(c1, 0, pn[2]); PINV(pn[2]); SB(); \
            o[3] = MFMA32(pa[0], vfa[0], o[3]); o[3] = MFMA32(pa[1], vfa[1], o[3]); SB(); \
            o[3] = MFMA32(pa[2], vfb[0], o[3]); o[3] = MFMA32(pa[3], vfb[1], o[3]); EXPPACK(c1, 8, pn[3]); PINV(pn[3]); SB(); \
            lacc = MFMA32(pa[0], ones8, lacc); lacc = MFMA32(pa[1], ones8, lacc); lacc = MFMA32(pa[2], ones8, lacc); lacc = MFMA32(pa[3], ones8, lacc); } while (0)
#define ATT_DRAIN(vb, pa) do { _Pragma("unroll") for (int d0 = 0; d0 < 4; ++d0) { bf16x8 vf[2]; VFRAG2(vf, vb, d0, 0); o[d0] = MFMA32(pa[0], vf[0], o[d0]); o[d0] = MFMA32(pa[1], vf[1], o[d0]); \
            VFRAG2(vf, vb, d0, 1); o[d0] = MFMA32(pa[2], vf[0], o[d0]); o[d0] = MFMA32(pa[3], vf[1], o[d0]); } \
            lacc = MFMA32(pa[0], ones8, lacc); lacc = MFMA32(pa[1], ones8, lacc); lacc = MFMA32(pa[2], ones8, lacc); lacc = MFMA32(pa[3], ones8, lacc); } while (0)
        int ks_cur = 1, ks_nn = 0;
        int vs_prev = 0, vs_nn = 3;
        bf16x8 pb[4];
#define ATT_ITER(PIN_, POUT_) do { \
            const bool more = (t + 2 < NT); \
            if (more) ATT_DMA(t + 2, ks_nn, vs_nn); \
            const LAS unsigned char* vb = vbase + vs_prev * ATT_VS; \
            const LAS unsigned char* kb = kbase + ks_cur * ATT_KS; \
            ATT_STEP(kb, vb, PIN_, POUT_); \
            if (more) { WAITV(4); } else { WAITV(0); } \
            ATT_BAR(); \
            ks_cur = (ks_cur == 2) ? 0 : ks_cur + 1; ks_nn = (ks_nn == 2) ? 0 : ks_nn + 1; \
            vs_prev = (vs_prev + 1) & 3; vs_nn = (vs_nn + 1) & 3; ++t; } while (0)
        for (int t = 1; t + 1 < NT;) { ATT_ITER(pa, pb); ATT_ITER(pb, pa); }
#undef ATT_ITER
        {
            const LAS unsigned char* vb = vbase + vs_prev * ATT_VS;
            if (myNT == NT) {
                const LAS unsigned char* kb = kbase + ks_cur * ATT_KS;
                ATT_STEP(kb, vb, pa, pb);
                const LAS unsigned char* vb2 = vbase + ((vs_prev + 1) & 3) * ATT_VS;
                ATT_DRAIN(vb2, pb);
            } else {
                ATT_DRAIN(vb, pa);
            }
        }
        __syncthreads();
#pragma unroll
        for (int r = 0; r < 16; ++r) { const float fr_ = (comp == 0) ? (1.0f / lacc[r]) : (lam / lacc[r]);
#pragma unroll
            for (int d0 = 0; d0 < 4; ++d0) o[d0][r] *= fr_; }
        LAS float* area = (LAS float*)lds;
        if (comp == 1) {
#pragma unroll
            for (int d0 = 0; d0 < 4; ++d0)
#pragma unroll
                for (int r = 0; r < 16; ++r) area[((wq * 4 + d0) * 16 + r) * 64 + lane] = o[d0][r];
        }
        __syncthreads();
        if (comp == 0) {
            float ssq[16];
#pragma unroll
            for (int r = 0; r < 16; ++r) { float a = 0.f;
#pragma unroll
                for (int d0 = 0; d0 < 4; ++d0) { o[d0][r] -= area[((wq * 4 + d0) * 16 + r) * 64 + lane]; a += o[d0][r] * o[d0][r]; }
                ssq[r] = a; }
#pragma unroll
            for (int r = 0; r < 16; ++r) {
                float a = ssq[r];
                a += shflx_l(a, 1, lane); a += shflx_l(a, 2, lane); a += shflx_l(a, 4, lane); a += shflx_l(a, 8, lane); a += shflx_l(a, 16, lane);
                ssq[r] = rsqrtf(a * (1.0f / 128.0f) + EPS);
            }
#pragma unroll
            for (int d0 = 0; d0 < 4; ++d0) {
                const float gsc = subg[32 * d0 + r32] * oscale;
#pragma unroll
                for (int r = 0; r < 16; ++r)
                    O[(rowbase + q0 + 32 * wq + crow(r, hi)) * DM + h * 128 + 32 * d0 + r32] = f2bf(o[d0][r] * ssq[r] * gsc);
            }
        }
        __syncthreads();
#undef ATT_DMA
#undef WAITV
#undef ATT_BAR
#undef ATT_STEP
#undef ATT_DRAIN
#undef SB
#undef KFRAG
#undef VFRAG2
#undef EXPPACK
#undef PINV
#undef MAX3
#undef ROWMAX32
    }
}

#define XB_TMO      128
#define XB_XCNT(j)  (256  + 64 * (j))
#define XB_XSUB(j)  (1280 + 64 * (j))
#define XB_XGEN(j)  (2304 + 64 * (j))
#define XB_TOP      3328
#define XB_TOPGEN   3392
#define XCD_BAR_WORDS 3456
#define XB_SPIN_CAP (1u << 18)
__device__ __forceinline__ unsigned xb_ld(unsigned* p)              { return __hip_atomic_load(p, __ATOMIC_RELAXED, __HIP_MEMORY_SCOPE_AGENT); }
__device__ __forceinline__ unsigned xb_add(unsigned* p, unsigned v) { return __hip_atomic_fetch_add(p, v, __ATOMIC_RELAXED, __HIP_MEMORY_SCOPE_AGENT); }
__device__ __forceinline__ unsigned xb_xcc_id() { return (unsigned)__builtin_amdgcn_s_getreg((3 << 11) | 20) & 0xFu; }
#define XB_SPIN(cond, bar) do { unsigned _sp = 0; while (cond) { __builtin_amdgcn_s_sleep(1); \
    if ((++_sp & 255u) == 0u) { if (xb_ld(&(bar)[XB_TMO])) break; if (_sp > XB_SPIN_CAP) { atomicAdd(&(bar)[XB_TMO], 1u); break; } } } } while (0)
struct XcdBarrier { unsigned* bar; unsigned x; volatile LAS unsigned* st; };
__device__ __forceinline__ XcdBarrier xcd_barrier_post(unsigned* bar, volatile LAS unsigned* st) {
    XcdBarrier b; b.bar = bar; b.x = xb_xcc_id(); b.st = st;
    if (threadIdx.x == 0) (void)xb_add(&bar[XB_XCNT(b.x)], 1u);
    return b;
}
__device__ __forceinline__ void xcd_barrier_complete(unsigned* bar, unsigned x, unsigned& nloc, unsigned& nx) {
    const unsigned G = gridDim.x * gridDim.y * gridDim.z;
    unsigned sum, cnt, mine, sp = 0u;
    for (;;) {
        sum = 0u; cnt = 0u; mine = 0u;
#pragma unroll
        for (unsigned j = 0; j < 16; ++j) { const unsigned c = xb_ld(&bar[XB_XCNT(j)]); sum += c; cnt += (c > 0u) ? 1u : 0u; mine = (j == x) ? c : mine; }
        if (sum == G) break;
        __builtin_amdgcn_s_sleep(1);
        if ((++sp & 255u) == 0u) { if (xb_ld(&bar[XB_TMO])) break; if (sp > XB_SPIN_CAP) { atomicAdd(&bar[XB_TMO], 1u); break; } }
    }
    nloc = mine > 0u ? mine : 1u; nx = cnt > 0u ? cnt : 1u;
}
__device__ __forceinline__ void xcd_barrier(const XcdBarrier& b) {
    asm volatile("s_waitcnt vmcnt(0)" ::: "memory");
    __syncthreads();
    if (threadIdx.x == 0) {
        unsigned* bar = b.bar;
        __builtin_amdgcn_s_waitcnt(0);
        unsigned nloc = b.st[0], nx = b.st[1];
        if (nloc == 0u) { xcd_barrier_complete(bar, b.x, nloc, nx); b.st[0] = nloc; b.st[1] = nx; }
        const unsigned old = xb_add(&bar[XB_XSUB(b.x)], 1u);
        const unsigned gen = old / nloc;
        if (old + 1u == (gen + 1u) * nloc) {
            __builtin_amdgcn_fence(__ATOMIC_RELEASE, "agent");
            asm volatile("s_waitcnt vmcnt(0)" ::: "memory");
            const unsigned og = xb_add(&bar[XB_TOP], 1u);
            const unsigned tg = og / nx;
            if (og + 1u == (tg + 1u) * nx) xb_add(&bar[XB_TOPGEN], 1u);
            else XB_SPIN(xb_ld(&bar[XB_TOPGEN]) == tg, bar);
            __builtin_amdgcn_fence(__ATOMIC_ACQUIRE, "agent");
            xb_add(&bar[XB_XGEN(b.x)], 1u);
            asm volatile("s_waitcnt vmcnt(0)" ::: "memory");
        } else {
            XB_SPIN(xb_ld(&bar[XB_XGEN(b.x)]) == gen, bar);
            __builtin_amdgcn_fence(__ATOMIC_ACQUIRE, "agent");
            asm volatile("s_waitcnt vmcnt(0)" ::: "memory");
        }
    }
    __syncthreads();
}

struct Frame {
    LAS unsigned char* lds;
    int wave, G, vcu;
};
typedef const __attribute__((address_space(4))) Args* KArgs;
#define KARGS(name) KArgs name = (KArgs)__builtin_amdgcn_kernarg_segment_ptr(); asm volatile("" : "+s"(name))


__device__ __forceinline__ int rowmap(int mode, int n, int nhalf) {
    if (mode == 1) { if (n >= 2048) return n; const int d = n & 63, base = n & ~63; const int q = (d & 31) >> 2, j = (d & 3) + ((d >> 5) << 2); return base + 8 * q + j; }
    if (mode == 2) { const int hsel = n >= nhalf ? 1 : 0, nn = n - hsel * nhalf; return 256 * (nn >> 7) + 128 * hsel + (nn & 127); }
    return n;
}
__device__ __forceinline__ void transpose_item(const float* W, int K, int N, bf16_t* WT, int mode, int nhalf, LAS float* scr, int item, int lane) {
    const int nblk = N / 32, kb = item / nblk, nb = item % nblk, k0 = 64 * kb, n0 = 32 * nb;
#pragma unroll 8
    for (int i = 0; i < 32; ++i) { const int kk = 2 * i + (lane >> 5); scr[kk * 33 + (lane & 31)] = W[(size_t)(k0 + kk) * N + n0 + (lane & 31)]; }
    asm volatile("s_waitcnt lgkmcnt(0)" ::: "memory");
    const int c = lane & 7;
#pragma unroll
    for (int j = 0; j < 4; ++j) { const int n = (lane >> 3) + 8 * j; const LAS float* s = scr + (8 * c) * 33 + n;
        u32x4 o; o.x = pk2(s[0 * 33], s[1 * 33]); o.y = pk2(s[2 * 33], s[3 * 33]); o.z = pk2(s[4 * 33], s[5 * 33]); o.w = pk2(s[6 * 33], s[7 * 33]);
        *(u32x4*)(WT + (size_t)rowmap(mode, n0 + n, nhalf) * K + k0 + 8 * c) = o; }
    asm volatile("s_waitcnt lgkmcnt(0)" ::: "memory");
}

__device__ __forceinline__ void prologue(Frame& F) {
    int tid = threadIdx.x; asm volatile("" : "+v"(tid));
    const int lane = tid & 63, wave = F.wave;
    KARGS(ap);
    unsigned char* ws = ap->ws;
    int vcu = F.vcu, G = F.G; OPQ_S(vcu); OPQ_S(G);
#define PIN(k) (ap->in[k])
    {
        LAS float* scr = (LAS float*)(F.lds + wave * 16384);
        const int gw = vcu * 8 + wave, NGW = G * 8;
        constexpr int I_GLU = 16 * 64, I_QKV = 16 * 96, I_WO = 16 * 32, I_WIN = 16 * 176, I_WOUT = 44 * 32;
        constexpr int NITEMS = 2 * I_GLU + 2 * I_QKV + 2 * I_WO + 4 * I_WIN + 4 * I_WOUT;
        for (int it = gw; it < NITEMS; it += NGW) {
            int r = it;
            if (r < 2 * I_GLU) { const int j = r / I_GLU; transpose_item(PIN(14) + (size_t)j * 1024 * 2048, 1024, 2048, (bf16_t*)(ws + WS_WGLU) + (size_t)j * 2048 * 1024, 2, 1024, scr, r % I_GLU, lane); continue; } r -= 2 * I_GLU;
            if (r < 2 * I_QKV) { const int j = r / I_QKV; transpose_item(PIN(15) + (size_t)j * 1024 * 3072, 1024, 3072, (bf16_t*)(ws + WS_WQKV) + (size_t)j * 3072 * 1024, 1, 0, scr, r % I_QKV, lane); continue; } r -= 2 * I_QKV;
            if (r < 2 * I_WO) { const int j = r / I_WO; transpose_item(PIN(16) + (size_t)j * 1024 * 1024, 1024, 1024, (bf16_t*)(ws + WS_WO) + (size_t)j * 1024 * 1024, 0, 0, scr, r % I_WO, lane); continue; } r -= 2 * I_WO;
            if (r < 4 * I_WIN) { const int j = r / I_WIN; transpose_item(PIN(22) + (size_t)j * 1024 * NFF2, 1024, NFF2, (bf16_t*)(ws + WS_WIN) + (size_t)j * NFF2 * 1024, 2, DFF, scr, r % I_WIN, lane); continue; } r -= 4 * I_WIN;
            { const int j = r / I_WOUT; transpose_item(PIN(25) + (size_t)j * DFF * 1024, DFF, 1024, (bf16_t*)(ws + WS_WOUT) + (size_t)j * 1024 * DFF, 0, 0, scr, r % I_WOUT, lane); }
        }
    }
    __syncthreads();
    {
        LAS float* sc = (LAS float*)F.lds;
        LAS float* red = (LAS float*)(F.lds + 32768);
        const float* cin = PIN(1);
        for (int i = tid; i < 8 * 1024; i += NTHR) { const float v = cin[i]; sc[i] = v / (1.0f + expf(-v)); }
        __syncthreads();
        float* mod = (float*)(ws + WS_MOD);
        const int kc = tid >> 6, col = tid & 63;
        for (int it = vcu; it < 4 * 96; it += G) {
            const int li = it / 96, n0 = (it % 96) * 64;
            const float* w = PIN(3) + (size_t)li * 1024 * 6144 + n0 + col;
            float acc[8];
#pragma unroll
            for (int b = 0; b < 8; ++b) acc[b] = 0.f;
#pragma unroll 8
            for (int k = kc * 128; k < kc * 128 + 128; ++k) { const float wv = w[(size_t)k * 6144];
#pragma unroll
                for (int b = 0; b < 8; ++b) acc[b] += sc[b * 1024 + k] * wv; }
#pragma unroll
            for (int b = 0; b < 8; ++b) red[(kc * 8 + b) * 64 + col] = acc[b];
            __syncthreads();
            { const int b = tid >> 6; float s = 0.f;
#pragma unroll
              for (int k2 = 0; k2 < 8; ++k2) s += red[(k2 * 8 + b) * 64 + col];
              mod[((size_t)li * 8 + b) * 6144 + n0 + col] = s + PIN(4)[(size_t)li * 6144 + n0 + col]; }
            __syncthreads();
        }
    }
    __syncthreads();
    {
        const int* pos = (const int*)PIN(2);
        float* cs = (float*)(ws + WS_CS);
        for (int i = vcu * NTHR + tid; i < MTOK * 32; i += G * NTHR) {
            const int m = i >> 5, f = i & 31;
            const double ang = (double)pos[m] * ap->invf[f];
            float s, c; sincos_d(ang, s, c);
            *(f32x2*)(cs + (size_t)i * 2) = (f32x2){c, s};
        }
    }
    if (vcu == 0 && tid < 2) {
        const int j = tid; float d1 = 0.f, d2 = 0.f;
        for (int k = 0; k < 64; ++k) { d1 += PIN(17)[j * 64 + k] * PIN(18)[j * 64 + k]; d2 += PIN(19)[j * 64 + k] * PIN(20)[j * 64 + k]; }
        ((float*)(ws + WS_SCAL))[j] = expf(d1) - expf(d2) + ap->lam_init[j];
    }
    {
        LAS float* Pr = (LAS float*)F.lds;
        LAS float* Pi = Pr + 17 * 64;
        LAS float* Bbr = Pi + 17 * 64;
        LAS float* Bbi = Bbr + 1024;
        LAS float* Ccr = Bbi + 1024;
        LAS float* Cci = Ccr + 1024;
        LAS float* Km = Cci + 1024;
        for (int it = vcu; it < 128; it += G) {
            const int j = it >> 6, g = it & 63;
            __syncthreads();
            if (tid < 64) {
                const int p = tid;
                const double lre = fmin((double)PIN(6)[(j * 64 + g) * 64 + p], -1e-4), lim = (double)PIN(7)[(j * 64 + g) * 64 + p];
                const double dt = exp((double)PIN(8)[j * 64 + g]);
                const double dre = lre * dt, dim_ = lim * dt;
                for (int n = 0; n <= 16; ++n) { float s, c; sincos_d((double)n * dim_, s, c); const double mag = exp((double)n * dre); Pr[n * 64 + p] = (float)(mag * c); Pi[n * 64 + p] = (float)(mag * s); }
                float s1, c1; sincos_d(dim_, s1, c1); const double mag1 = exp(dre);
                const double lbr = mag1 * (double)c1, lbi = mag1 * (double)s1;
                const double nr = expm1(dre) * (double)c1 + ((double)c1 - 1.0);
                const double nr2 = (fabs(dim_) < 0.5) ? (expm1(dre) * (double)c1 - 2.0 * sin(0.5 * dim_) * sin(0.5 * dim_)) : nr;
                const double den = lre * lre + lim * lim;
                const double fre = (nr2 * lre + lbi * lim) / den, fim = (lbi * lre - nr2 * lim) / den;
                (void)lbr;
                for (int c = 0; c < 16; ++c) {
                    const double br = (double)PIN(9)[((size_t)(j * 64 + g) * 64 + p) * 16 + c], bi = (double)PIN(10)[((size_t)(j * 64 + g) * 64 + p) * 16 + c];
                    Bbr[p * 16 + c] = (float)(fre * br - fim * bi); Bbi[p * 16 + c] = (float)(fre * bi + fim * br);
                }
                float* a16 = (float*)(ws + WS_A16) + ((size_t)(j * 64 + g) * 64 + p) * 2;
                a16[0] = Pr[16 * 64 + p]; a16[1] = Pi[16 * 64 + p];
            }
            for (int i = tid; i < 1024; i += NTHR) { Ccr[i] = PIN(11)[(size_t)(j * 64 + g) * 1024 + i]; Cci[i] = PIN(12)[(size_t)(j * 64 + g) * 1024 + i]; }
            __syncthreads();
            for (int i = tid; i < 4096; i += NTHR) {
                const int tau = i >> 8, c = (i >> 4) & 15, c2 = i & 15; float a = 0.f;
                for (int p = 0; p < 64; ++p) {
                    const float cr = Ccr[c * 64 + p], ci = Cci[c * 64 + p], pr = Pr[tau * 64 + p], pi = Pi[tau * 64 + p];
                    const float cpr = cr * pr - ci * pi, cpi = cr * pi + ci * pr;
                    a += cpr * Bbr[p * 16 + c2] - cpi * Bbi[p * 16 + c2];
                }
                Km[i] = a;
            }
            __syncthreads();
            bf16_t* W2 = (bf16_t*)(ws + WS_S5W2) + (size_t)(j * 64 + g) * 256 * 384;
            for (int i = tid; i < 256 * 384; i += NTHR) {
                const int n = i / 384, k = i % 384, t = n >> 4, c = n & 15; float v;
                if (k < 256) { const int s = k >> 4, c2 = k & 15; v = (t >= s) ? Km[((t - s) * 16 + c) * 16 + c2] : 0.f; }
                else { const int q = k - 256, p = q & 63; const float cr = Ccr[c * 64 + p], ci = Cci[c * 64 + p], pr = Pr[(t + 1) * 64 + p], pi = Pi[(t + 1) * 64 + p];
                    v = (q < 64) ? (cr * pr - ci * pi) : -(cr * pi + ci * pr); }
                W2[i] = f2bf(v);
            }
            bf16_t* W1 = (bf16_t*)(ws + WS_S5W1) + (size_t)(j * 64 + g) * 256 * 256;
            for (int i = tid; i < 256 * 256; i += NTHR) {
                const int n = i >> 8, k = i & 255; float v = 0.f;
                if (n < 128) { const int p = n & 63, s = k >> 4, c2 = k & 15; const float pr = Pr[(15 - s) * 64 + p], pi = Pi[(15 - s) * 64 + p], br = Bbr[p * 16 + c2], bi = Bbi[p * 16 + c2];
                    v = (n < 64) ? (pr * br - pi * bi) : (pr * bi + pi * br); }
                W1[i] = f2bf(v);
            }
        }
    }
    __syncthreads();
#undef PIN
}

struct RowP { const float* xsrc; float* xdst; const bf16_t* H; const float* gate; const float* gH; const float* gX; const float* shift; const float* scale; bf16_t* XN; int mode; };
__device__ __forceinline__ void row_phase(Frame& F, const RowP& P) {
    int lane = threadIdx.x & 63; asm volatile("" : "+v"(lane));
    int vcu = F.vcu, G = F.G, wave = F.wave; OPQ_S(vcu); OPQ_S(G); OPQ_S(wave);
    for (int blk = vcu; blk < MTOK / 32; blk += G) {
        const int row0 = blk * 32 + wave * 4;
        const int b = row0 >> 12;
        f32x4 x[4][4]; u32x2 hw[4][4];
#pragma unroll
        for (int r = 0; r < 4; ++r)
#pragma unroll
            for (int j = 0; j < 4; ++j) x[r][j] = __builtin_nontemporal_load((const f32x4*)(P.xsrc + (size_t)(row0 + r) * DM + 4 * lane + 256 * j));
        if (P.H) {
#pragma unroll
            for (int r = 0; r < 4; ++r)
#pragma unroll
                for (int j = 0; j < 4; ++j) hw[r][j] = *(const u32x2*)(P.H + (size_t)(row0 + r) * DM + 4 * lane + 256 * j);
            float rs[4];
#pragma unroll
            for (int r = 0; r < 4; ++r) { float s = 0.f;
#pragma unroll
                for (int j = 0; j < 4; ++j) { const float h0 = bflo(hw[r][j].x), h1 = bfhi(hw[r][j].x), h2 = bflo(hw[r][j].y), h3 = bfhi(hw[r][j].y); s += (h0 * h0 + h1 * h1) + (h2 * h2 + h3 * h3); }
                rs[r] = s; }
#pragma unroll
            for (int o = 1; o < 64; o <<= 1) {
#pragma unroll
                for (int r = 0; r < 4; ++r) rs[r] += shflx_l(rs[r], o, lane); }
#pragma unroll
            for (int r = 0; r < 4; ++r) rs[r] = rsqrtf(rs[r] * (1.0f / DM) + EPS);
#pragma unroll
            for (int j = 0; j < 4; ++j) {
                const f32x4 gt = *(const f32x4*)(P.gate + b * 6144 + 4 * lane + 256 * j), gh = *(const f32x4*)(P.gH + 4 * lane + 256 * j);
                const f32x4 gg = gt * gh;
#pragma unroll
                for (int r = 0; r < 4; ++r) {
                    const f32x4 hv = {bflo(hw[r][j].x), bfhi(hw[r][j].x), bflo(hw[r][j].y), bfhi(hw[r][j].y)};
                    x[r][j] = x[r][j] + gg * (hv * rs[r]);
                    __builtin_nontemporal_store(x[r][j], (f32x4*)(P.xdst + (size_t)(row0 + r) * DM + 4 * lane + 256 * j));
                }
            }
        }
        if (P.mode) {
            float rs[4];
#pragma unroll
            for (int r = 0; r < 4; ++r) { float s = 0.f;
#pragma unroll
                for (int j = 0; j < 4; ++j) s += (x[r][j][0] * x[r][j][0] + x[r][j][1] * x[r][j][1]) + (x[r][j][2] * x[r][j][2] + x[r][j][3] * x[r][j][3]);
                rs[r] = s; }
#pragma unroll
            for (int o = 1; o < 64; o <<= 1) {
#pragma unroll
                for (int r = 0; r < 4; ++r) rs[r] += shflx_l(rs[r], o, lane); }
#pragma unroll
            for (int r = 0; r < 4; ++r) rs[r] = rsqrtf(rs[r] * (1.0f / DM) + EPS);
#pragma unroll
            for (int j = 0; j < 4; ++j) {
                const int d = 4 * lane + 256 * j;
                const f32x4 gx = *(const f32x4*)(P.gX + d), sh = *(const f32x4*)(P.shift + b * 6144 + d), sc = *(const f32x4*)(P.scale + b * 6144 + d);
                const f32x4 gs = gx * (sc + 1.0f);
#pragma unroll
                for (int r = 0; r < 4; ++r) {
                    const int l = (row0 + r) & 4095;
                    const f32x4 v = (x[r][j] * rs[r]) * gs + sh;
                    u32x2 w; w.x = pk2(v[0], v[1]); w.y = pk2(v[2], v[3]);
                    if (P.mode == 1) *(u32x2*)(P.XN + (size_t)(row0 + r) * DM + d) = w;
                    else { const int g = d >> 4, c = d & 15; *(u32x2*)(P.XN + ((size_t)g * 2048 + b * 256 + (l >> 4)) * 384 + (l & 15) * 16 + c) = w; }
                }
            }
        }
    }
}

__device__ __forceinline__ void s5_scan(Frame& F, const float* HL, bf16_t* S5A, const float* A16) {
    int lane = threadIdx.x & 63; asm volatile("" : "+v"(lane));
    int vcu = F.vcu, G = F.G, wave = F.wave; OPQ_S(vcu); OPQ_S(G); OPQ_S(wave);
    for (int wi = wave * G + vcu; wi < 512; wi += 8 * G) {
        const int g = wi >> 3, b = wi & 7;
        const float ar = A16[(g * 64 + lane) * 2], ai = A16[(g * 64 + lane) * 2 + 1];
        float hr = 0.f, hi = 0.f;
        const size_t row0 = (size_t)g * 2048 + b * 256;
#pragma unroll 8
        for (int k = 0; k < 256; ++k) {
            const float lr = HL[(row0 + k) * 128 + lane], li = HL[(row0 + k) * 128 + 64 + lane];
            S5A[(row0 + k) * 384 + 256 + lane] = f2bf(hr); S5A[(row0 + k) * 384 + 320 + lane] = f2bf(hi);
            const float nr = ar * hr - ai * hi + lr, ni = ar * hi + ai * hr + li;
            hr = nr; hi = ni;
        }
    }
}

__device__ __forceinline__ void conv_fixup(Frame& F, const float* halo, bf16_t* Gout, const float* cw, const float* cb) {
    constexpr int NQ = DFF / 4;
    int tid0 = threadIdx.x; asm volatile("" : "+v"(tid0));
    int vcu = F.vcu, G = F.G; OPQ_S(vcu); OPQ_S(G);
    for (int i = vcu * NTHR + tid0; i < 512 * 2 * NQ; i += G * NTHR) {
        const int cq = i % NQ, rj = i / NQ, j = rj & 1, s = rj >> 1;
        const int ca = cq * 4, cbc = DFF + ca;
        const bool first = (s & 63) == 0;
        const float* h0 = halo + (size_t)s * 4 * NFF2; const float* hm = halo + (size_t)(s - 1) * 4 * NFF2;
        const f32x4 z = {0.f, 0.f, 0.f, 0.f};
        f32x4 a0, a1, a2, b0, b1, b2;
        if (j == 0) { a0 = *(const f32x4*)(h0 + ca); b0 = *(const f32x4*)(h0 + cbc);
            a1 = first ? z : *(const f32x4*)(hm + 3 * NFF2 + ca); b1 = first ? z : *(const f32x4*)(hm + 3 * NFF2 + cbc);
            a2 = first ? z : *(const f32x4*)(hm + 2 * NFF2 + ca); b2 = first ? z : *(const f32x4*)(hm + 2 * NFF2 + cbc); }
        else { a0 = *(const f32x4*)(h0 + NFF2 + ca); b0 = *(const f32x4*)(h0 + NFF2 + cbc);
            a1 = *(const f32x4*)(h0 + ca); b1 = *(const f32x4*)(h0 + cbc);
            a2 = first ? z : *(const f32x4*)(hm + 3 * NFF2 + ca); b2 = first ? z : *(const f32x4*)(hm + 3 * NFF2 + cbc); }
        const f32x4 w0a = *(const f32x4*)(cw + ca), w1a = *(const f32x4*)(cw + NFF2 + ca), w2a = *(const f32x4*)(cw + 2 * NFF2 + ca), ba = *(const f32x4*)(cb + ca);
        const f32x4 w0b = *(const f32x4*)(cw + cbc), w1b = *(const f32x4*)(cw + NFF2 + cbc), w2b = *(const f32x4*)(cw + 2 * NFF2 + cbc), bb = *(const f32x4*)(cb + cbc);
        float o[4];
#pragma unroll
        for (int e = 0; e < 4; ++e) { const float ua = ba[e] + w2a[e] * a0[e] + w1a[e] * a1[e] + w0a[e] * a2[e]; const float ub = bb[e] + w2b[e] * b0[e] + w1b[e] * b1[e] + w0b[e] * b2[e]; o[e] = gelu_tanh(ua) * ub; }
        u32x2 w; w.x = pk2(o[0], o[1]); w.y = pk2(o[2], o[3]);
        *(u32x2*)(Gout + (size_t)(64 * s + j) * DFF + ca) = w;
    }
}

#ifndef REP_PRO
#define REP_PRO 1
#endif
#ifndef REP_S5
#define REP_S5 1
#endif
#ifndef REP_QKV
#define REP_QKV 1
#endif
#ifndef REP_ATT
#define REP_ATT 1
#endif
#ifndef REP_WO
#define REP_WO 1
#endif
#ifndef REP_FFN
#define REP_FFN 1
#endif
__global__ void __launch_bounds__(NTHR, 2) mega_fwd(Args args) {
    extern __shared__ __attribute__((aligned(16))) unsigned char lds_raw[];
    cg::grid_group grid = cg::this_grid();
    Frame F;
    F.lds = (LAS unsigned char*)lds_raw;
    F.wave = __builtin_amdgcn_readfirstlane((int)threadIdx.x >> 6);
    F.G = gridDim.x; { const int bx = blockIdx.x; F.vcu = (F.G % 8 == 0) ? (bx % 8) * (F.G / 8) + bx / 8 : bx; }
    volatile LAS unsigned* bst = (volatile LAS unsigned*)(F.lds + 131072 + 256);
    if (threadIdx.x < 2) bst[threadIdx.x] = 0u;
    __syncthreads();
    const XcdBarrier xbar = xcd_barrier_post((unsigned*)args.ws, bst);
#define GSYNC() xcd_barrier(xbar)

    for (int rep = 0; rep < REP_PRO; ++rep) { prologue(F); grid.sync(); }

#pragma unroll 1
    for (int li_ = 0; li_ <= DEPTH; ++li_) {
        {
            KARGS(ap); int li = li_; OPQ_S(li);
            unsigned char* ws = ap->ws; const float* mod = (const float*)(ws + WS_MOD); const float* ng = ap->in[5];
            const bool s5 = (li & 1) == 0;
            const float* modl = mod + (size_t)li * 8 * 6144;
            RowP P;
            P.xsrc = (li == 0) ? ap->in[0] : ap->out; P.xdst = ap->out;
            P.H = (li == 0) ? nullptr : (const bf16_t*)(ws + WS_H); P.gate = (li == 0) ? nullptr : (mod + (size_t)(li - 1) * 8 * 6144 + 5 * 1024); P.gH = (li == 0) ? nullptr : (ng + ((li - 1) * 4 + 3) * 1024);
            P.gX = ng + (li * 4 + 0) * 1024; P.shift = modl; P.scale = modl + 1024;
            P.XN = s5 ? (bf16_t*)(ws + WS_SCR + SCR_S5A) : (bf16_t*)(ws + WS_XN); P.mode = (li == DEPTH) ? 0 : (s5 ? 2 : 1);
            row_phase(F, P);
        }
        if (li_ == DEPTH) break;
        GSYNC();
        if ((li_ & 1) == 0) {
          for (int rep = 0; rep < REP_S5; ++rep) {
            {
                KARGS(ap); int j = li_ >> 1; OPQ_S(j); unsigned char* ws = ap->ws;
                pg8::Gemm g{(const bf16_t*)(ws + WS_SCR + SCR_S5A), (const bf16_t*)(ws + WS_S5W1) + (size_t)j * 64 * 256 * 256, 384, 256, 256}; pg8::S5Order S{opqi(F.G), opqi((int)blockIdx.x)}; pg8::EpiHL E{(float*)(ws + WS_SCR + SCR_HL)};
                pg8::gemm_phase(F.lds, g, S, E);
            }
            GSYNC();
            {
                KARGS(ap); int j = li_ >> 1; OPQ_S(j); unsigned char* ws = ap->ws;
                s5_scan(F, (const float*)(ws + WS_SCR + SCR_HL), (bf16_t*)(ws + WS_SCR + SCR_S5A), (const float*)(ws + WS_A16) + (size_t)j * 64 * 64 * 2);
            }
            GSYNC();
            {
                KARGS(ap); int j = li_ >> 1; OPQ_S(j); unsigned char* ws = ap->ws;
                pg8::Gemm g{(const bf16_t*)(ws + WS_SCR + SCR_S5A), (const bf16_t*)(ws + WS_S5W2) + (size_t)j * 64 * 256 * 384, 384, 384, 384}; pg8::S5Order S{opqi(F.G), opqi((int)blockIdx.x)};
                pg8::EpiS5Y E{(const bf16_t*)(ws + WS_SCR + SCR_S5A), (bf16_t*)(ws + WS_SCR + SCR_Z), ap->in[13] + j * 1024};
                pg8::gemm_phase(F.lds, g, S, E);
            }
            GSYNC();
            {
                KARGS(ap); int j = li_ >> 1; OPQ_S(j); unsigned char* ws = ap->ws;
                pg8::Gemm g{(const bf16_t*)(ws + WS_SCR + SCR_Z), (const bf16_t*)(ws + WS_WGLU) + (size_t)j * 2048 * 1024, 1024, 1024, 1024}; pg8::StaticOrder S; S.init(MTOK, 2048, opqi(F.G), opqi((int)blockIdx.x)); pg8::EpiGLU E{(bf16_t*)(ws + WS_H)};
                pg8::gemm_phase(F.lds, g, S, E);
            }
            GSYNC();
          }
        } else {
          for (int rep = 0; rep < REP_QKV; ++rep) {
            {
                KARGS(ap); int j = li_ >> 1; OPQ_S(j); unsigned char* ws = ap->ws;
                const bf16_t* Wqkv = (const bf16_t*)(ws + WS_WQKV) + (size_t)j * 3072 * 1024;
                pg8::Gemm g{(const bf16_t*)(ws + WS_XN), Wqkv, 1024, 1024, 1024}; pg8::StaticOrder S; S.init(MTOK, 2048, opqi(F.G), opqi((int)blockIdx.x));
                pg8::EpiQK E{(bf16_t*)(ws + WS_SCR + SCR_Q), (bf16_t*)(ws + WS_SCR + SCR_K), (const float*)(ws + WS_CS), 0.125f * 1.4426950408889634f};
                pg8::gemm_phase(F.lds, g, S, E);
            }
            {
                KARGS(ap); int j = li_ >> 1; OPQ_S(j); unsigned char* ws = ap->ws;
                const bf16_t* Wqkv = (const bf16_t*)(ws + WS_WQKV) + (size_t)j * 3072 * 1024;
                pg8::Gemm g{Wqkv + (size_t)2048 * 1024, (const bf16_t*)(ws + WS_XN), 1024, 1024, 1024}; pg8::StaticOrder S; S.init(1024, MTOK, opqi(F.G), opqi((int)blockIdx.x)); pg8::EpiVt E{(bf16_t*)(ws + WS_SCR + SCR_VT)};
                pg8::gemm_phase(F.lds, g, S, E);
            }
            GSYNC();
          }
          for (int rep = 0; rep < REP_ATT; ++rep) {
            {
                KARGS(ap); int j = li_ >> 1; OPQ_S(j); unsigned char* ws = ap->ws;
                bf16_t* Qb = (bf16_t*)(ws + WS_SCR + SCR_Q);
                attn_phase(F.lds, Qb, (const bf16_t*)(ws + WS_SCR + SCR_K), (const bf16_t*)(ws + WS_SCR + SCR_VT), (bf16_t*)(ws + WS_XN), ap->in[21] + j * 128, ((const float*)(ws + WS_SCAL))[j], 1.0f - ap->lam_init[j], F.G, F.vcu);
            }
            GSYNC();
          }
          for (int rep = 0; rep < REP_WO; ++rep) {
            {
                KARGS(ap); int j = li_ >> 1; OPQ_S(j); unsigned char* ws = ap->ws;
                pg8::Gemm g{(const bf16_t*)(ws + WS_XN), (const bf16_t*)(ws + WS_WO) + (size_t)j * 1024 * 1024, 1024, 1024, 1024}; pg8::StaticOrder S; S.init(MTOK, 1024, opqi(F.G), opqi((int)blockIdx.x)); pg8::EpiPlain E{(bf16_t*)(ws + WS_H), 1024};
                pg8::gemm_phase(F.lds, g, S, E);
            }
            GSYNC();
          }
        }
        {
            KARGS(ap); int li = li_; OPQ_S(li);
            unsigned char* ws = ap->ws; const float* mod = (const float*)(ws + WS_MOD); const float* ng = ap->in[5];
            const float* modl = mod + (size_t)li * 8 * 6144;
            RowP P;
            P.xsrc = (li == 0) ? ap->in[0] : ap->out; P.xdst = ap->out;
            P.H = (const bf16_t*)(ws + WS_H); P.gate = modl + 2 * 1024; P.gH = ng + (li * 4 + 1) * 1024;
            P.gX = ng + (li * 4 + 2) * 1024; P.shift = modl + 3 * 1024; P.scale = modl + 4 * 1024;
            P.XN = (bf16_t*)(ws + WS_XN); P.mode = 1;
            row_phase(F, P);
        }
        GSYNC();
        for (int rep = 0; rep < REP_FFN; ++rep) {
        {
            KARGS(ap); int li = li_; OPQ_S(li); unsigned char* ws = ap->ws;
            pg8::Gemm g{(const bf16_t*)(ws + WS_XN), (const bf16_t*)(ws + WS_WIN) + (size_t)li * NFF2 * 1024, 1024, 1024, 1024}; pg8::StaticOrder S; S.init(MTOK, NFF2, opqi(F.G), opqi((int)blockIdx.x));
            pg8::EpiWin E{(bf16_t*)(ws + WS_SCR + SCR_G), (float*)(ws + WS_SCR + SCR_HALO), ap->in[23] + (size_t)li * 3 * NFF2, ap->in[24] + (size_t)li * NFF2};
            pg8::gemm_phase(F.lds, g, S, E);
        }
        GSYNC();
        {
            KARGS(ap); int li = li_; OPQ_S(li); unsigned char* ws = ap->ws;
            conv_fixup(F, (const float*)(ws + WS_SCR + SCR_HALO), (bf16_t*)(ws + WS_SCR + SCR_G), ap->in[23] + (size_t)li * 3 * NFF2, ap->in[24] + (size_t)li * NFF2);
        }
        GSYNC();
        {
            KARGS(ap); int li = li_; OPQ_S(li); unsigned char* ws = ap->ws;
            pg8::Gemm g{(const bf16_t*)(ws + WS_SCR + SCR_G), (const bf16_t*)(ws + WS_WOUT) + (size_t)li * 1024 * DFF, DFF, DFF, DFF}; pg8::StaticOrder S; S.init(MTOK, 1024, opqi(F.G), opqi((int)blockIdx.x)); pg8::EpiPlain E{(bf16_t*)(ws + WS_H), 1024};
            pg8::gemm_phase(F.lds, g, S, E);
        }
        GSYNC();
        }
    }
}

extern "C" void kernel_launch(void* const* d_in, const int* in_sizes, int n_in, void* d_out, int out_size, void* d_ws, size_t ws_size, hipStream_t stream) {
    static int grid = 0;
    if (grid == 0) {
        if (n_in != 26 || out_size != MTOK * DM || ws_size < WS_END) { fprintf(stderr, "kernel_launch: unexpected shapes (n_in %d out %d ws %zu need %zu)\n", n_in, out_size, ws_size, (size_t)WS_END); grid = -1; return; }
        int dev = 0, cus = 0, per_cu = 0;
        hipGetDevice(&dev);
        hipDeviceGetAttribute(&cus, hipDeviceAttributeMultiprocessorCount, dev);
        if (hipFuncSetAttribute((const void*)mega_fwd, hipFuncAttributeMaxDynamicSharedMemorySize, LDS_BYTES) != hipSuccess) { fprintf(stderr, "kernel_launch: hipFuncSetAttribute failed\n"); grid = -1; return; }
        if (hipOccupancyMaxActiveBlocksPerMultiprocessor(&per_cu, (const void*)mega_fwd, NTHR, LDS_BYTES) != hipSuccess || per_cu < 1) { fprintf(stderr, "kernel_launch: occupancy query failed (%d)\n", per_cu); per_cu = 1; }
        (void)hipGetLastError();
        grid = cus * per_cu;
    }
    if (grid < 0) return;
    Args a{};
    for (int i = 0; i < 26; ++i) a.in[i] = (const float*)d_in[i];
    a.out = (float*)d_out; a.ws = (unsigned char*)d_ws;
    for (int f = 0; f < 32; ++f) a.invf[f] = pow(10000.0, -(double)f / 32.0);
    a.lam_init[0] = (float)(0.8 - 0.6 * exp(-0.3 * 1.0));
    a.lam_init[1] = (float)(0.8 - 0.6 * exp(-0.3 * 3.0));
    if (hipMemsetAsync(d_ws, 0, 16384, stream) != hipSuccess) { fprintf(stderr, "kernel_launch: memset of barrier words failed\n"); return; }
    void* kargs[] = {&a};
    hipError_t e = hipLaunchCooperativeKernel((const void*)mega_fwd, dim3(grid), dim3(NTHR), kargs, LDS_BYTES, stream);
    if (e != hipSuccess) fprintf(stderr, "cooperative launch failed: %s (grid %d)\n", hipGetErrorString(e), grid);
}
```

```cpp
#include <hip/hip_runtime.h>
#include <hip/hip_cooperative_groups.h>
#include <cstdio>
#include <cstdint>
#include <cmath>
namespace cg = cooperative_groups;

#define LAS __attribute__((address_space(3)))
typedef unsigned short bf16_t;
typedef short bf16x8 __attribute__((ext_vector_type(8)));
typedef float f32x4 __attribute__((ext_vector_type(4)));
typedef float f32x2 __attribute__((ext_vector_type(2)));
typedef float f32x16 __attribute__((ext_vector_type(16)));
typedef unsigned u32x4 __attribute__((ext_vector_type(4)));
typedef unsigned u32x2 __attribute__((ext_vector_type(2)));
typedef __bf16 bf16x2_t __attribute__((ext_vector_type(2)));

constexpr int DM = 1024, NB = 8, SEQ = 4096, MTOK = NB * SEQ, DEPTH = 4, DFF = 2816, NFF2 = 2 * DFF;
constexpr float EPS = 1e-6f;
constexpr int NTHR = 512;
constexpr int LDS_BYTES = 147456;

constexpr size_t MiB = 1u << 20;
constexpr size_t WS_MOD = 1 * MiB;
constexpr size_t WS_SCAL = WS_MOD + 800 * 1024;
constexpr size_t WS_A16 = WS_SCAL + 4096;
constexpr size_t WS_CS = 2 * MiB;
constexpr size_t WS_WGLU = 10 * MiB;
constexpr size_t WS_WQKV = 18 * MiB;
constexpr size_t WS_WO = 30 * MiB;
constexpr size_t WS_WIN = 34 * MiB;
constexpr size_t WS_WOUT = 78 * MiB;
constexpr size_t WS_S5W1 = 100 * MiB;
constexpr size_t WS_S5W2 = 116 * MiB;
constexpr size_t WS_XN = 140 * MiB;
constexpr size_t WS_H = 204 * MiB;
constexpr size_t WS_SCR = 268 * MiB;
constexpr size_t WS_END = 492 * MiB;
constexpr size_t SCR_S5A = 0;
constexpr size_t SCR_HL = 96 * MiB;
constexpr size_t SCR_Z = 160 * MiB;
constexpr size_t SCR_Q = 0;
constexpr size_t SCR_K = 64 * MiB;
constexpr size_t SCR_VT = 128 * MiB;
constexpr size_t SCR_G = 0;
constexpr size_t SCR_HALO = 176 * MiB;

struct Args {
    const float* in[26];
    float* out;
    unsigned char* ws;
    double invf[32];
    float lam_init[2];
    int pad[2];
};

#define OPQ_S(x) asm volatile("" : "+s"(x))
__device__ __forceinline__ int opqi(int x) { OPQ_S(x); return x; }
#define DPPF(old, src, ctrl) __int_as_float(__builtin_amdgcn_update_dpp(__float_as_int(old), __float_as_int(src), (ctrl), 0xf, 0xf, false))
__device__ __forceinline__ unsigned pk2(float lo, float hi) { f32x2 v = {lo, hi}; bf16x2_t b = __builtin_convertvector(v, bf16x2_t); return __builtin_bit_cast(unsigned, b); }
__device__ __forceinline__ bf16_t f2bf(float f) { return (bf16_t)(pk2(f, 0.f) & 0xffffu); }
__device__ __forceinline__ float bflo(unsigned u) { return __uint_as_float(u << 16); }
__device__ __forceinline__ float bfhi(unsigned u) { return __uint_as_float(u & 0xffff0000u); }
__device__ __forceinline__ float fast_sigmoid(float x) { return __builtin_amdgcn_rcpf(1.0f + __builtin_amdgcn_exp2f(-1.4426950408889634f * x)); }
__device__ __forceinline__ float gelu_tanh(float y) { const float x2 = 1.5957691216057308f * (y + 0.044715f * y * y * y); return y * fast_sigmoid(x2); }
__device__ __forceinline__ float shfl_l(float v, int src) { return __int_as_float(__builtin_amdgcn_ds_bpermute(src << 2, __float_as_int(v))); }
__device__ __forceinline__ float shflx_l(float v, int mask, int lane) { return shfl_l(v, lane ^ mask); }
__device__ __forceinline__ float wave_sum(float v, int lane) {
#pragma unroll
    for (int o = 1; o < 64; o <<= 1) v += shflx_l(v, o, lane);
    return v;
}
__device__ __forceinline__ void sincos_d(double a, float& s, float& c) {
    const double k = rint(a * 0.15915494309189535);
    double r = fma(-k, 6.283185307179586, a);
    r = fma(-k, 2.4492935982947064e-16, r);
    const float rf = (float)r;
    s = sinf(rf); c = cosf(rf);
}

namespace pg8 {
constexpr int BM = 256, BK = 64, HALF = 128, HTB = HALF * BK * 2, STAGE_BYTES = 8 * HTB, NXCD = 8, WGM = 8;
__host__ __device__ __forceinline__ int lds_byte(int r, int c) { const int st = (r >> 4) * 2 + (c >> 5), rr = r & 15, cc = c & 31, ob = rr * 64 + cc * 2; return st * 1024 + (ob ^ (((ob >> 9) & 1) << 5)); }
__host__ __device__ __forceinline__ void stage_rc(int b, int& R, int& C) { const int st = b / 1024, sb = b % 1024, swz = sb ^ (((sb >> 9) & 1) << 5); R = (st >> 1) * 16 + swz / 64; C = (st & 1) * 32 + (swz % 64) / 2; }
__host__ __device__ __forceinline__ int perm32(int rho) { const int n = rho >> 4, i = rho & 15; return 8 * (i >> 2) + 4 * n + (i & 3); }

struct Unit { int pm, pn; };
struct Gemm { const bf16_t* A; const bf16_t* Bt; int lda, ldb, K; };

struct StaticOrder {
    int nM, nN, nwg, G, c;
    __device__ void init(int M, int N, int G_, int c_) { nM = M / BM; nN = N / BM; nwg = nM * nN; G = G_; c = c_; }
    __device__ bool next(int i, Unit& u) const {
        const long L = (long)i * G + c; if (L >= nwg) return false;
        int wgid = (int)L; { const int q = nwg / NXCD, r = nwg % NXCD, xcd = wgid % NXCD, off = wgid / NXCD; wgid = (xcd < r ? xcd * (q + 1) : r * (q + 1) + (xcd - r) * q) + off; }
        const int nig = WGM * nN, gid = wgid / nig, fm = gid * WGM, gsz = (nM - fm) < WGM ? (nM - fm) : WGM;
        u.pm = fm + ((wgid % nig) % gsz); u.pn = (wgid % nig) / gsz; return true;
    }
};
struct S5Order {
    int G, c;
    __device__ bool next(int i, Unit& u) const { const int L = i * G + c; if (L >= 512) return false; u.pm = L; u.pn = L >> 3; return true; }
};

typedef f32x4 Acc[2][2][4][2];

struct EpiPlain {
    static constexpr bool APERM = false;
    bf16_t* O; int ldc;
    __device__ __forceinline__ void operator()(const Acc& acc, const Unit& u, int wr, int wc, int fr, int fq) const {
        const int row0 = u.pm * BM + wr * 64 + fr, col0 = u.pn * BM + wc * 32 + 8 * fq;
#pragma unroll
        for (int ai = 0; ai < 2; ++ai)
#pragma unroll
            for (int m = 0; m < 4; ++m) { bf16_t* rowp = O + (size_t)(row0 + ai * HALF + m * 16) * ldc + col0;
#pragma unroll
                for (int bj = 0; bj < 2; ++bj) { const f32x4 v0 = acc[ai][bj][m][0], v1 = acc[ai][bj][m][1];
                    u32x4 w; w.x = pk2(v0[0], v0[1]); w.y = pk2(v0[2], v0[3]); w.z = pk2(v1[0], v1[1]); w.w = pk2(v1[2], v1[3]);
                    *(u32x4*)(rowp + bj * HALF) = w; } }
    }
};
struct EpiVt {
    static constexpr bool APERM = false;
    bf16_t* O;
    __device__ __forceinline__ void operator()(const Acc& acc, const Unit& u, int wr, int wc, int fr, int fq) const {
        const int row0 = u.pm * BM + wr * 64 + fr, col0 = u.pn * BM + wc * 32 + 8 * fq;
#pragma unroll
        for (int ai = 0; ai < 2; ++ai)
#pragma unroll
            for (int m = 0; m < 4; ++m) { const int row = row0 + ai * HALF + m * 16, h = row >> 7, e = row & 127;
#pragma unroll
                for (int bj = 0; bj < 2; ++bj) { const int col = col0 + bj * HALF, b = col >> 12, l = col & 4095;
                    const f32x4 v0 = acc[ai][bj][m][0], v1 = acc[ai][bj][m][1];
                    u32x4 w; w.x = pk2(v0[0], v0[1]); w.y = pk2(v0[2], v0[3]); w.z = pk2(v1[0], v1[1]); w.w = pk2(v1[2], v1[3]);
                    *(u32x4*)(O + ((size_t)(((b * 8 + h) * 64 + (l >> 6)) * 128 + e)) * 64 + (l & 63)) = w; } }
    }
};
struct EpiHL {
    static constexpr bool APERM = false;
    float* HL;
    __device__ __forceinline__ void operator()(const Acc& acc, const Unit& u, int wr, int wc, int fr, int fq) const {
        const int row0 = u.pm * BM + wr * 64 + fr, col0 = wc * 32 + 8 * fq;
#pragma unroll
        for (int ai = 0; ai < 2; ++ai)
#pragma unroll
            for (int m = 0; m < 4; ++m) { float* rowp = HL + (size_t)(row0 + ai * HALF + m * 16) * 128 + col0;
                *(f32x4*)(rowp) = acc[ai][0][m][0]; *(f32x4*)(rowp + 4) = acc[ai][0][m][1]; }
    }
};
struct EpiS5Y {
    static constexpr bool APERM = false;
    const bf16_t* A; bf16_t* Z; const float* dskip;
    __device__ __forceinline__ void operator()(const Acc& acc, const Unit& u, int wr, int wc, int fr, int fq) const {
        const int g = u.pn;
        const int row0 = u.pm * BM + wr * 64 + fr;
        const int d0 = 16 * g + 8 * (fq & 1);
#pragma unroll
        for (int ai = 0; ai < 2; ++ai)
#pragma unroll
            for (int m = 0; m < 4; ++m) {
                const int R = row0 + ai * HALF + m * 16;
#pragma unroll
                for (int bj = 0; bj < 2; ++bj) {
                    const int n0 = 128 * bj + 32 * wc + 8 * fq, t = n0 >> 4;
                    int Ro = R; asm volatile("" : "+v"(Ro));
                    const u32x4 uu = *(const u32x4*)((const char*)A + (unsigned)((Ro * 384 + n0) * 2));
                    const f32x4 ds0 = *(const f32x4*)(dskip + d0), ds1 = *(const f32x4*)(dskip + d0 + 4);
                    const f32x4 v0 = acc[ai][bj][m][0], v1 = acc[ai][bj][m][1];
                    u32x4 w;
                    w.x = pk2(gelu_tanh(v0[0] + ds0[0] * bflo(uu.x)), gelu_tanh(v0[1] + ds0[1] * bfhi(uu.x)));
                    w.y = pk2(gelu_tanh(v0[2] + ds0[2] * bflo(uu.y)), gelu_tanh(v0[3] + ds0[3] * bfhi(uu.y)));
                    w.z = pk2(gelu_tanh(v1[0] + ds1[0] * bflo(uu.z)), gelu_tanh(v1[1] + ds1[1] * bfhi(uu.z)));
                    w.w = pk2(gelu_tanh(v1[2] + ds1[2] * bflo(uu.w)), gelu_tanh(v1[3] + ds1[3] * bfhi(uu.w)));
                    const int mp = Ro - g * 2048, b = mp >> 8, k = mp & 255;
                    const unsigned tok = (unsigned)(b * SEQ + 16 * k + t);
                    *(u32x4*)((char*)Z + (tok * (unsigned)DM + (unsigned)d0) * 2u) = w;
                    asm volatile("" ::: "memory");
                }
            }
    }
};
struct EpiGLU {
    static constexpr bool APERM = false;
    bf16_t* H;
    __device__ __forceinline__ void operator()(const Acc& acc, const Unit& u, int wr, int wc, int fr, int fq) const {
        const int row0 = u.pm * BM + wr * 64 + fr, col0 = u.pn * HALF + wc * 32 + 8 * fq;
#pragma unroll
        for (int ai = 0; ai < 2; ++ai)
#pragma unroll
            for (int m = 0; m < 4; ++m) {
                float o[8];
#pragma unroll
                for (int n = 0; n < 2; ++n)
#pragma unroll
                    for (int i = 0; i < 4; ++i) o[4 * n + i] = acc[ai][0][m][n][i] * fast_sigmoid(acc[ai][1][m][n][i]);
                u32x4 w; w.x = pk2(o[0], o[1]); w.y = pk2(o[2], o[3]); w.z = pk2(o[4], o[5]); w.w = pk2(o[6], o[7]);
                *(u32x4*)(H + (size_t)(row0 + ai * HALF + m * 16) * DM + col0) = w;
            }
    }
};
struct EpiQK {
    static constexpr bool APERM = false;
    bf16_t* Q; bf16_t* Kb; const float* cs; float qscale;
    __device__ __forceinline__ void operator()(const Acc& acc, const Unit& u, int wr, int wc, int fr, int fq) const {
        const bool isq = u.pn < 4;
        bf16_t* dst = isq ? Q : Kb; const int colbase = (isq ? u.pn : u.pn - 4) * BM; const float sc = isq ? qscale : 1.0f;
        const int row0 = u.pm * BM + wr * 64 + fr;
        const int q8 = 4 * (wc & 1) + fq;
#pragma unroll
        for (int ai = 0; ai < 2; ++ai)
#pragma unroll
            for (int m = 0; m < 4; ++m) {
                const int R = row0 + ai * HALF + m * 16;
                const f32x4 cs0 = *(const f32x4*)(cs + (size_t)R * 64 + 8 * q8), cs1 = *(const f32x4*)(cs + (size_t)R * 64 + 8 * q8 + 4);
                const float cc[4] = {cs0[0], cs0[2], cs1[0], cs1[2]}, ss[4] = {cs0[1], cs0[3], cs1[1], cs1[3]};
#pragma unroll
                for (int bj = 0; bj < 2; ++bj) {
                    const f32x4 lo = acc[ai][bj][m][0], hi = acc[ai][bj][m][1];
                    float ol[4], oh[4];
#pragma unroll
                    for (int i = 0; i < 4; ++i) { ol[i] = (lo[i] * cc[i] - hi[i] * ss[i]) * sc; oh[i] = (hi[i] * cc[i] + lo[i] * ss[i]) * sc; }
                    u32x4 w; w.x = pk2(ol[0], ol[1]); w.y = pk2(ol[2], ol[3]); w.z = pk2(oh[0], oh[1]); w.w = pk2(oh[2], oh[3]);
                    const int col = colbase + 128 * bj + 32 * wc + 8 * fq;
                    if (isq) *(u32x4*)(dst + (size_t)R * DM + col) = w;
                    else { const int b = R >> 12, l = R & 4095, kv = l & 63, slot = (kv & ~12) | ((kv & 4) << 1) | ((kv & 8) >> 1);
                        *(u32x4*)(dst + ((size_t)(((b * 16 + (col >> 6)) * 64 + (l >> 6)) * 64 + slot)) * 64 + (col & 63)) = w; }
                }
                asm volatile("" ::: "memory");
            }
    }
};
__device__ __forceinline__ f32x4 dpp_shr1_4(f32x4 v) { f32x4 r;
#pragma unroll
    for (int i = 0; i < 4; ++i) r[i] = __int_as_float(__builtin_amdgcn_update_dpp(0, __float_as_int(v[i]), 0x111, 0xf, 0xf, true));
    return r; }
__device__ __forceinline__ f32x4 gelu4(f32x4 y) {
    const f32x4 t = y * ((y * y) * (-0.10294324f) + (-2.30220819f));
    f32x4 r;
#pragma unroll
    for (int i = 0; i < 4; ++i) r[i] = __builtin_amdgcn_exp2f(t[i]);
    r = r + 1.0f;
#pragma unroll
    for (int i = 0; i < 4; ++i) r[i] = __builtin_amdgcn_rcpf(r[i]);
    return y * r;
}
struct EpiWin {
    static constexpr bool APERM = true;
    bf16_t* Gout; float* halo; const float* cw; const float* cb;
    __device__ __forceinline__ void operator()(const Acc& acc, const Unit& u, int wr, int wc, int fr, int fq) const {
        const int row0 = u.pm * BM + wr * 64 + 4 * fr;
#pragma unroll
        for (int n = 0; n < 2; ++n) {
            const int ca = u.pn * HALF + wc * 32 + 8 * fq + 4 * n, cbc = DFF + ca;
            const f32x4 w0a = *(const f32x4*)(cw + ca), w1a = *(const f32x4*)(cw + NFF2 + ca), w2a = *(const f32x4*)(cw + 2 * NFF2 + ca), ba = *(const f32x4*)(cb + ca);
            const f32x4 w0b = *(const f32x4*)(cw + cbc), w1b = *(const f32x4*)(cw + NFF2 + cbc), w2b = *(const f32x4*)(cw + 2 * NFF2 + cbc), bb = *(const f32x4*)(cb + cbc);
#pragma unroll
            for (int ai = 0; ai < 2; ++ai) {
                const int strip = (u.pm * BM + ai * HALF + wr * 64) >> 6;
                const f32x4 a0 = acc[ai][0][0][n], a1 = acc[ai][0][1][n], a2 = acc[ai][0][2][n], a3 = acc[ai][0][3][n];
                const f32x4 b0 = acc[ai][1][0][n], b1 = acc[ai][1][1][n], b2 = acc[ai][1][2][n], b3 = acc[ai][1][3][n];
                const f32x4 sa3 = dpp_shr1_4(a3), sa2 = dpp_shr1_4(a2), sb3 = dpp_shr1_4(b3), sb2 = dpp_shr1_4(b2);
                f32x4 o[4];
                o[3] = gelu4(ba + w2a * a3 + w1a * a2 + w0a * a1) * (bb + w2b * b3 + w1b * b2 + w0b * b1);
                o[2] = gelu4(ba + w2a * a2 + w1a * a1 + w0a * a0) * (bb + w2b * b2 + w1b * b1 + w0b * b0);
                o[1] = gelu4(ba + w2a * a1 + w1a * a0 + w0a * sa3) * (bb + w2b * b1 + w1b * b0 + w0b * sb3);
                o[0] = gelu4(ba + w2a * a0 + w1a * sa3 + w0a * sa2) * (bb + w2b * b0 + w1b * sb3 + w0b * sb2);
                bf16_t* gp = Gout + (size_t)(row0 + ai * HALF) * DFF + ca;
#pragma unroll
                for (int m = 0; m < 4; ++m) {
                    if (!(fr == 0 && m < 2)) { u32x2 w; w.x = pk2(o[m][0], o[m][1]); w.y = pk2(o[m][2], o[m][3]); *(u32x2*)(gp + (size_t)m * DFF) = w; }
                }
                if (fr == 0) { float* hp = halo + (size_t)strip * 4 * NFF2; *(f32x4*)(hp + ca) = a0; *(f32x4*)(hp + cbc) = b0; *(f32x4*)(hp + NFF2 + ca) = a1; *(f32x4*)(hp + NFF2 + cbc) = b1; }
                if (fr == 15) { float* hp = halo + ((size_t)strip * 4 + 2) * NFF2; *(f32x4*)(hp + ca) = a2; *(f32x4*)(hp + cbc) = b2; *(f32x4*)(hp + NFF2 + ca) = a3; *(f32x4*)(hp + NFF2 + cbc) = b3; }
                asm volatile("" ::: "memory");
            }
        }
    }
};

template <class Epi, class Sched>
__device__ __forceinline__ void gemm_phase(LAS unsigned char* lds, const Gemm g, const Sched& S, const Epi& E) {
    int tid = threadIdx.x; asm volatile("" : "+v"(tid));
    const int wid = __builtin_amdgcn_readfirstlane(tid >> 6), lane = tid & 63, wr = wid >> 2, wc = wid & 3, fr = lane & 15, fq = lane >> 4;
    const int K = g.K, nt = K / BK;
    unsigned voffA[2], voffB[2];
#pragma unroll
    for (int i = 0; i < 2; ++i) { int R, C; stage_rc(tid * 16 + i * 8192, R, C); const int Rb = (R & ~31) + perm32(R & 31);
        const int Ra = Epi::APERM ? ((R & ~63) + 4 * (R & 15) + ((R >> 4) & 3)) : R;
        voffA[i] = (unsigned)(Ra * g.lda + C) * 2u; voffB[i] = (unsigned)(Rb * g.ldb + C) * 2u; }
    const size_t kstep = (size_t)(BK * 2);
    const size_t hstepA = (size_t)HALF * g.lda * 2, hstepB = (size_t)HALF * g.ldb * 2;
    const size_t tstepA = 2 * hstepA, tstepB = 2 * hstepB;
    const unsigned ldsw = (unsigned)wid * 1024u;
    const int aoff = lds_byte(wr * 64 + fr, fq * 8), boff = lds_byte(wc * 32 + fr, fq * 8);
#define PG8_SA(b, h) (((b) * 2 + (h)) * HTB)
#define PG8_SB(b, h) ((4 + (b) * 2 + (h)) * HTB)
#define PG8_STAGE(bufoff, gbase, voff) do { _Pragma("unroll") for (int _i = 0; _i < 2; ++_i) \
        __builtin_amdgcn_global_load_lds((const unsigned*)((const char*)(gbase) + (voff)[_i]), (LAS unsigned*)(lds + (bufoff) + ldsw + _i * 8192), 16, 0, 0); } while (0)
#define PG8_LDA(dst, b, h) do { _Pragma("unroll") for (int m = 0; m < 4; ++m) _Pragma("unroll") for (int k = 0; k < 2; ++k) dst[m][k] = *(const LAS bf16x8*)(lds + PG8_SA(b, h) + aoff + m * 2048 + k * 1024); } while (0)
#define PG8_LDB(dst, b, h) do { _Pragma("unroll") for (int n = 0; n < 2; ++n) _Pragma("unroll") for (int k = 0; k < 2; ++k) dst[n][k] = *(const LAS bf16x8*)(lds + PG8_SB(b, h) + boff + n * 2048 + k * 1024); } while (0)
#define PG8_MMA(ai, bj, At, Bt) do { __builtin_amdgcn_s_setprio(1); _Pragma("unroll") for (int m = 0; m < 4; ++m) _Pragma("unroll") for (int n = 0; n < 2; ++n) _Pragma("unroll") for (int k = 0; k < 2; ++k) \
        acc[ai][bj][m][n] = __builtin_amdgcn_mfma_f32_16x16x32_bf16(Bt[n][k], At[m][k], acc[ai][bj][m][n], 0, 0, 0); __builtin_amdgcn_s_setprio(0); } while (0)
#define PG8_WAIT_V(n) asm volatile("s_waitcnt vmcnt(" #n ")" ::: "memory")
#define PG8_WAIT_L(n) asm volatile("s_waitcnt lgkmcnt(" #n ")" ::: "memory")
#define PG8_BAR __builtin_amdgcn_s_barrier()
#define PG8_SCHED __builtin_amdgcn_sched_barrier(0)
    Unit cur, nxt; int ui = 0;
    if (!S.next(0, cur)) return;
    Acc acc;
#pragma unroll
    for (int a = 0; a < 2; ++a)
#pragma unroll
        for (int b = 0; b < 2; ++b)
#pragma unroll
            for (int m = 0; m < 4; ++m)
#pragma unroll
                for (int n = 0; n < 2; ++n) acc[a][b][m][n] = (f32x4){0.f, 0.f, 0.f, 0.f};
    bf16x8 At[4][2], B0[2][2], B1[2][2];
    const char* cA = (const char*)g.A + (size_t)cur.pm * tstepA; const char* cB = (const char*)g.Bt + (size_t)cur.pn * tstepB;
    PG8_STAGE(PG8_SB(0, 0), cB, voffB); PG8_STAGE(PG8_SB(0, 1), cB + hstepB, voffB); PG8_STAGE(PG8_SA(0, 0), cA, voffA); PG8_STAGE(PG8_SA(0, 1), cA + hstepA, voffA);
    if (wr == 1) PG8_BAR;
    PG8_WAIT_V(2); PG8_BAR;
    PG8_STAGE(PG8_SB(1, 0), cB + kstep, voffB); PG8_STAGE(PG8_SA(1, 0), cA + kstep, voffA); PG8_STAGE(PG8_SB(1, 1), cB + hstepB + kstep, voffB);
    PG8_WAIT_V(6); PG8_BAR;
    for (;;) {
        const bool has_next = S.next(ui + 1, nxt);
        const char* nA = has_next ? (const char*)g.A + (size_t)nxt.pm * tstepA : cA; const char* nB = has_next ? (const char*)g.Bt + (size_t)nxt.pn * tstepB : cB;
#pragma unroll 1
        for (int t = 0; t < nt; t += 2) {
            const bool last = (t == nt - 2);
            const char* a1 = cA + (size_t)(t + 1) * kstep;
            const char* a2 = last ? nA : cA + (size_t)(t + 2) * kstep; const char* b2 = last ? nB : cB + (size_t)(t + 2) * kstep;
            const char* a3 = a2 + kstep; const char* b3 = b2 + kstep;
            PG8_LDB(B0, 0, 0); PG8_LDB(B1, 0, 1); PG8_SCHED; PG8_LDA(At, 0, 0); PG8_STAGE(PG8_SA(1, 1), a1 + hstepA, voffA);
            PG8_WAIT_V(8); PG8_WAIT_L(0); PG8_BAR; PG8_MMA(0, 0, At, B0); PG8_MMA(0, 1, At, B1); PG8_BAR; PG8_SCHED;
            PG8_LDA(At, 0, 1); PG8_STAGE(PG8_SB(0, 0), b2, voffB); PG8_STAGE(PG8_SB(0, 1), b2 + hstepB, voffB); PG8_STAGE(PG8_SA(0, 0), a2, voffA);
            PG8_WAIT_V(8); PG8_WAIT_L(0); PG8_BAR; PG8_MMA(1, 0, At, B0); PG8_MMA(1, 1, At, B1); PG8_BAR; PG8_SCHED;
            PG8_LDB(B0, 1, 0); PG8_LDB(B1, 1, 1); PG8_SCHED; PG8_LDA(At, 1, 0); PG8_STAGE(PG8_SA(0, 1), a2 + hstepA, voffA);
            PG8_WAIT_V(8); PG8_WAIT_L(0); PG8_BAR; PG8_MMA(0, 0, At, B0); PG8_MMA(0, 1, At, B1); PG8_BAR; PG8_SCHED;
            PG8_LDA(At, 1, 1); PG8_STAGE(PG8_SB(1, 0), b3, voffB); PG8_STAGE(PG8_SB(1, 1), b3 + hstepB, voffB); PG8_STAGE(PG8_SA(1, 0), a3, voffA);
            PG8_WAIT_V(8); PG8_WAIT_L(0); PG8_BAR; PG8_MMA(1, 0, At, B0); PG8_MMA(1, 1, At, B1); PG8_BAR; PG8_SCHED;
        }
        if (wr == 0) PG8_BAR;
        E(acc, cur, wr, wc, fr, fq);
        if (!has_next) break;
#pragma unroll
        for (int a = 0; a < 2; ++a)
#pragma unroll
            for (int b = 0; b < 2; ++b)
#pragma unroll
                for (int m = 0; m < 4; ++m)
#pragma unroll
                    for (int n = 0; n < 2; ++n) acc[a][b][m][n] = (f32x4){0.f, 0.f, 0.f, 0.f};
        cur = nxt; cA = nA; cB = nB; ++ui;
        if (wr == 1) PG8_BAR;
    }
    PG8_WAIT_V(0);
    PG8_BAR;
#undef PG8_SA
#undef PG8_SB
#undef PG8_STAGE
#undef PG8_LDA
#undef PG8_LDB
#undef PG8_MMA
#undef PG8_WAIT_V
#undef PG8_WAIT_L
#undef PG8_BAR
#undef PG8_SCHED
}
}

#define MFMA32(a, b, c) __builtin_amdgcn_mfma_f32_32x32x16_bf16((a), (b), (c), 0, 0, 0)
__device__ __forceinline__ int crow(int r, int hi) { return (r & 3) + 8 * (r >> 2) + 4 * hi; }
constexpr int ATT_KS = 16384;
constexpr int ATT_VS = 16384;
constexpr int ATT_V0 = 3 * ATT_KS;
__device__ __forceinline__ void glds16(const void* gsrc, unsigned lds_dst) { unsigned keep;
    asm volatile("s_mov_b32 %0, m0\n\ts_mov_b32 m0, %2\n\ts_nop 0\n\tglobal_load_lds_dwordx4 %1, off\n\ts_mov_b32 m0, %0" : "=&s"(keep) : "v"(gsrc), "s"(lds_dst) : "memory"); }

__device__ __forceinline__ void attn_phase(LAS unsigned char* lds, const bf16_t* Q, const bf16_t* Kb, const bf16_t* Vt, bf16_t* O,
                                           const float* subg, float lam, float oscale, int G, int vcu) {
    int tid = threadIdx.x; asm volatile("" : "+v"(tid));
    const int lane = tid & 63, wid = __builtin_amdgcn_readfirstlane(tid >> 6);
    const int r32 = lane & 31, hi = lane >> 5, comp = wid >> 2, wq = wid & 3;
    const unsigned lds0 = (unsigned)(uintptr_t)lds;
    OPQ_S(vcu); OPQ_S(G);
    const int drow = 8 * wid + (lane >> 3);
    const unsigned dsrc = (unsigned)(drow * 128 + (((lane & 7) ^ ((drow >> 1) & 7)) * 16));
    int foff[4];
#pragma unroll
    for (int x = 0; x < 4; ++x) foff[x] = r32 * 128 + (((2 * x + hi) ^ ((r32 >> 1) & 7)) * 16);
    for (int it = vcu * 2; it < 2048; it += ((it & 1) ? 2 * G - 1 : 1)) {
        const int su = it >> 1, half = it & 1;
        const int rr = su >> 8, v = su & 255, xcd = v >> 5, loc = v & 31, grp = loc >> 4, j16 = loc & 15;
        const int bh = xcd * 8 + rr * 2 + grp;
        const int qb = half ? j16 : 31 - j16;
        const int b = bh >> 3, h = bh & 7;
        const size_t rowbase = (size_t)b * SEQ; const int q0 = qb * 128;
        bf16x8 qr[4];
        { const bf16_t* qp = Q + (rowbase + q0 + 32 * wq + r32) * DM + (2 * h + comp) * 64 + hi * 8;
#pragma unroll
          for (int d0 = 0; d0 < 4; ++d0) qr[d0] = *(const bf16x8*)(qp + d0 * 16); }
        const int NT = 2 * qb + 2, myNT = (wq < 2) ? NT - 1 : NT;
        const char* kg = (const char*)(Kb + (size_t)((b * 16 + 2 * h) * 64) * 4096) + dsrc;
        const char* vg = (const char*)(Vt + (size_t)((b * 8 + h) * 64) * 8192) + dsrc;
        const unsigned kdst = lds0 + (unsigned)wid * 1024u, vdst = lds0 + ATT_V0 + (unsigned)wid * 1024u;
#define ATT_DMA(t, ks, vs) do { const char* kp_ = kg + (size_t)(t) * 8192; const char* vp_ = vg + (size_t)(t) * 16384; \
        glds16(kp_, (unsigned)__builtin_amdgcn_readfirstlane(kdst + (ks) * ATT_KS)); glds16(kp_ + 64 * 8192, (unsigned)__builtin_amdgcn_readfirstlane(kdst + (ks) * ATT_KS + 8192)); \
        glds16(vp_, (unsigned)__builtin_amdgcn_readfirstlane(vdst + (vs) * ATT_VS)); glds16(vp_ + 8192, (unsigned)__builtin_amdgcn_readfirstlane(vdst + (vs) * ATT_VS + 8192)); } while (0)
#define WAITV(n) asm volatile("s_waitcnt vmcnt(" #n ")" ::: "memory")
#define ATT_BAR() do { asm volatile("s_waitcnt lgkmcnt(0)" ::: "memory"); __builtin_amdgcn_s_barrier(); asm volatile("" ::: "memory"); } while (0)
#define SB() __builtin_amdgcn_sched_barrier(0)
#define KFRAG(dst, kb_, d0) do { dst[0] = *(const LAS bf16x8*)((kb_) + foff[d0]); dst[1] = *(const LAS bf16x8*)((kb_) + 4096 + foff[d0]); } while (0)
#define VFRAG2(dst, vb_, d0, kh) do { dst[0] = *(const LAS bf16x8*)((vb_) + (d0) * 4096 + foff[2 * (kh)]); dst[1] = *(const LAS bf16x8*)((vb_) + (d0) * 4096 + foff[2 * (kh) + 1]); } while (0)
#define EXPPACK(C, B, dst) do { float e_[8]; _Pragma("unroll") for (int j_ = 0; j_ < 8; ++j_) e_[j_] = __builtin_amdgcn_exp2f(C[(B) + j_]); \
        u32x4 w_; w_.x = pk2(e_[0], e_[1]); w_.y = pk2(e_[2], e_[3]); w_.z = pk2(e_[4], e_[5]); w_.w = pk2(e_[6], e_[7]); dst = __builtin_bit_cast(bf16x8, w_); } while (0)
#define PINV(x) asm volatile("" : "+v"(x))
#define MAX3(a, b, c) ({ float mx3_; asm("v_max3_f32 %0, %1, %2, %3" : "=v"(mx3_) : "v"(a), "v"(b), "v"(c)); mx3_; })
#define ROWMAX32(c0, c1) ({ float a_ = MAX3(c0[0], c0[1], c1[0]), b_ = MAX3(c0[2], c0[3], c1[1]); a_ = MAX3(a_, c1[2], c1[3]); \
        _Pragma("unroll") for (int r_ = 4; r_ < 16; r_ += 4) { a_ = MAX3(a_, c0[r_], c0[r_ + 1]); b_ = MAX3(b_, c0[r_ + 2], c0[r_ + 3]); a_ = MAX3(a_, c1[r_], c1[r_ + 1]); b_ = MAX3(b_, c1[r_ + 2], c1[r_ + 3]); } \
        MAX3(a_, b_, b_); })
        f32x16 o[4], negm, lacc;
        const f32x16 zero16 = {0.f, 0.f, 0.f, 0.f, 0.f, 0.f, 0.f, 0.f, 0.f, 0.f, 0.f, 0.f, 0.f, 0.f, 0.f, 0.f};
        const bf16x8 ones8 = {(short)0x3F80, (short)0x3F80, (short)0x3F80, (short)0x3F80, (short)0x3F80, (short)0x3F80, (short)0x3F80, (short)0x3F80};
#pragma unroll
        for (int d0 = 0; d0 < 4; ++d0) o[d0] = zero16;
        lacc = zero16;
        bf16x8 pa[4];
        const LAS unsigned char* kbase = lds + comp * 8192;
        const LAS unsigned char* vbase = lds + ATT_V0;
        ATT_DMA(0, 0, 0);
        ATT_DMA(1, 1, 1);
        if (NT > 2) { ATT_DMA(2, 2, 2); WAITV(8); } else { WAITV(4); }
        ATT_BAR();
        {
            f32x16 c0, c1;
#pragma unroll
            for (int d0 = 0; d0 < 4; ++d0) { bf16x8 kf[2]; KFRAG(kf, kbase, d0);
                if (d0 == 0) { c0 = MFMA32(kf[0], qr[0], zero16); c1 = MFMA32(kf[1], qr[0], zero16); } else { c0 = MFMA32(kf[0], qr[d0], c0); c1 = MFMA32(kf[1], qr[d0], c1); } }
            float mx = ROWMAX32(c0, c1);
            mx = fmaxf(mx, shflx_l(mx, 32, lane));
#pragma unroll
            for (int r = 0; r < 16; ++r) { c0[r] -= mx; c1[r] -= mx; negm[r] = -mx; }
            asm volatile("" : "+v"(negm));
            EXPPACK(c0, 0, pa[0]); EXPPACK(c0, 8, pa[1]); EXPPACK(c1, 0, pa[2]); EXPPACK(c1, 8, pa[3]);
        }
        if (NT > 2) { WAITV(4); } else { WAITV(0); }
        ATT_BAR();
#define ATT_STEP(kb, vb, pa, pn) do { \
            f32x16 c0, c1; bf16x8 kfa[2], kfb[2], vfa[2], vfb[2]; \
            SB(); \
            KFRAG(kfa, kb, 0); KFRAG(kfb, kb, 1); \
            c0 = MFMA32(kfa[0], qr[0], negm); c1 = MFMA32(kfa[1], qr[0], negm); \
            KFRAG(kfa, kb, 2); \
            c0 = MFMA32(kfb[0], qr[1], c0); c1 = MFMA32(kfb[1], qr[1], c1); \
            KFRAG(kfb, kb, 3); \
            c0 = MFMA32(kfa[0], qr[2], c0); c1 = MFMA32(kfa[1], qr[2], c1); \
            VFRAG2(vfa, vb, 0, 0); \
            c0 = MFMA32(kfb[0], qr[3], c0); c1 = MFMA32(kfb[1], qr[3], c1); \
            VFRAG2(vfb, vb, 0, 1); \
            SB(); \
            o[0] = MFMA32(pa[0], vfa[0], o[0]); o[0] = MFMA32(pa[1], vfa[1], o[0]); VFRAG2(vfa, vb, 1, 0); SB(); \
            o[0] = MFMA32(pa[2], vfb[0], o[0]); o[0] = MFMA32(pa[3], vfb[1], o[0]); VFRAG2(vfb, vb, 1, 1); EXPPACK(c0, 0, pn[0]); PINV(pn[0]); SB(); \
            o[1] = MFMA32(pa[0], vfa[0], o[1]); o[1] = MFMA32(pa[1], vfa[1], o[1]); VFRAG2(vfa, vb, 2, 0); SB(); \
            o[1] = MFMA32(pa[2], vfb[0], o[1]); o[1] = MFMA32(pa[3], vfb[1], o[1]); VFRAG2(vfb, vb, 2, 1); EXPPACK(c0, 8, pn[1]); PINV(pn[1]); SB(); \
            o[2] = MFMA32(pa[0], vfa[0], o[2]); o[2] = MFMA32(pa[1], vfa[1], o[2]); VFRAG2(vfa, vb, 3, 0); SB(); \
            o[2] = MFMA32(pa[2], vfb[0], o[2]); o[2] = MFMA32(pa[3], vfb[1], o[2]); VFRAG2(vfb, vb, 3, 1); EXPPACK(c1, 0, pn[2]); PINV(pn[2]); SB(); \
            o[3] = MFMA32(pa[0], vfa[0], o[3]); o[3] = MFMA32(pa[1], vfa[1], o[3]); SB(); \
            o[3] = MFMA32(pa[2], vfb[0], o[3]); o[3] = MFMA32(pa[3], vfb[1], o[3]); EXPPACK(c1, 8, pn[3]); PINV(pn[3]); SB(); \
            lacc = MFMA32(pa[0], ones8, lacc); lacc = MFMA32(pa[1], ones8, lacc); lacc = MFMA32(pa[2], ones8, lacc); lacc = MFMA32(pa[3], ones8, lacc); } while (0)
#define ATT_DRAIN(vb, pa) do { _Pragma("unroll") for (int d0 = 0; d0 < 4; ++d0) { bf16x8 vf[2]; VFRAG2(vf, vb, d0, 0); o[d0] = MFMA32(pa[0], vf[0], o[d0]); o[d0] = MFMA32(pa[1], vf[1], o[d0]); \
            VFRAG2(vf, vb, d0, 1); o[d0] = MFMA32(pa[2], vf[0], o[d0]); o[d0] = MFMA32(pa[3], vf[1], o[d0]); } \
            lacc = MFMA32(pa[0], ones8, lacc); lacc = MFMA32(pa[1], ones8, lacc); lacc = MFMA32(pa[2], ones8, lacc); lacc = MFMA32(pa[3], ones8, lacc); } while (0)
        int ks_cur = 1, ks_nn = 0;
        int vs_prev = 0, vs_nn = 3;
        bf16x8 pb[4];
#define ATT_ITER(PIN_, POUT_) do { \
            const bool more = (t + 2 < NT); \
            if (more) ATT_DMA(t + 2, ks_nn, vs_nn); \
            const LAS unsigned char* vb = vbase + vs_prev * ATT_VS; \
            const LAS unsigned char* kb = kbase + ks_cur * ATT_KS; \
            ATT_STEP(kb, vb, PIN_, POUT_); \
            if (more) { WAITV(4); } else { WAITV(0); } \
            ATT_BAR(); \
            ks_cur = (ks_cur == 2) ? 0 : ks_cur + 1; ks_nn = (ks_nn == 2) ? 0 : ks_nn + 1; \
            vs_prev = (vs_prev + 1) & 3; vs_nn = (vs_nn + 1) & 3; ++t; } while (0)
        for (int t = 1; t + 1 < NT;) { ATT_ITER(pa, pb); ATT_ITER(pb, pa); }
#undef ATT_ITER
        {
            const LAS unsigned char* vb = vbase + vs_prev * ATT_VS;
            if (myNT == NT) {
                const LAS unsigned char* kb = kbase + ks_cur * ATT_KS;
                ATT_STEP(kb, vb, pa, pb);
                const LAS unsigned char* vb2 = vbase + ((vs_prev + 1) & 3) * ATT_VS;
                ATT_DRAIN(vb2, pb);
            } else {
                ATT_DRAIN(vb, pa);
            }
        }
        __syncthreads();
#pragma unroll
        for (int r = 0; r < 16; ++r) { const float fr_ = (comp == 0) ? (1.0f / lacc[r]) : (lam / lacc[r]);
#pragma unroll
            for (int d0 = 0; d0 < 4; ++d0) o[d0][r] *= fr_; }
        LAS float* area = (LAS float*)lds;
        if (comp == 1) {
#pragma unroll
            for (int d0 = 0; d0 < 4; ++d0)
#pragma unroll
                for (int r = 0; r < 16; ++r) area[((wq * 4 + d0) * 16 + r) * 64 + lane] = o[d0][r];
        }
        __syncthreads();
        if (comp == 0) {
            float ssq[16];
#pragma unroll
            for (int r = 0; r < 16; ++r) { float a = 0.f;
#pragma unroll
                for (int d0 = 0; d0 < 4; ++d0) { o[d0][r] -= area[((wq * 4 + d0) * 16 + r) * 64 + lane]; a += o[d0][r] * o[d0][r]; }
                ssq[r] = a; }
#pragma unroll
            for (int r = 0; r < 16; ++r) {
                float a = ssq[r];
                a += shflx_l(a, 1, lane); a += shflx_l(a, 2, lane); a += shflx_l(a, 4, lane); a += shflx_l(a, 8, lane); a += shflx_l(a, 16, lane);
                ssq[r] = rsqrtf(a * (1.0f / 128.0f) + EPS);
            }
            const int odd = lane & 1;
#pragma unroll
            for (int d0 = 0; d0 < 4; ++d0) {
                const float gsc = subg[32 * d0 + r32] * oscale;
                bf16_t* Ol = O + (rowbase + q0 + 32 * wq + 4 * hi + odd) * DM + h * 128 + 32 * d0 + (r32 & ~1);
                asm volatile("" : "+v"(Ol));
#pragma unroll
                for (int r = 0; r < 16; r += 2) {
                    const float A = o[d0][r] * ssq[r] * gsc, B = o[d0][r + 1] * ssq[r + 1] * gsc;
                    const float X = odd ? A : B;
                    const float Y = __int_as_float(__builtin_amdgcn_update_dpp(0, __float_as_int(X), 0xB1, 0xf, 0xf, true));
                    const unsigned w = odd ? pk2(Y, B) : pk2(A, Y);
                    *(unsigned*)(Ol + (size_t)((r & 3) + 8 * (r >> 2)) * DM) = w;
                }
            }
        }
        __syncthreads();
#undef ATT_DMA
#undef WAITV
#undef ATT_BAR
#undef ATT_STEP
#undef ATT_DRAIN
#undef SB
#undef KFRAG
#undef VFRAG2
#undef EXPPACK
#undef PINV
#undef MAX3
#undef ROWMAX32
    }
}

#define XB_TMO      128
#define XB_XCNT(j)  (256  + 64 * (j))
#define XB_XSUB(j)  (1280 + 64 * (j))
#define XB_XGEN(j)  (2304 + 64 * (j))
#define XB_TOP      3328
#define XB_TOPGEN   3392
#define XCD_BAR_WORDS 3456
#define XB_SPIN_CAP (1u << 18)
__device__ __forceinline__ unsigned xb_ld(unsigned* p)              { return __hip_atomic_load(p, __ATOMIC_RELAXED, __HIP_MEMORY_SCOPE_AGENT); }
__device__ __forceinline__ unsigned xb_add(unsigned* p, unsigned v) { return __hip_atomic_fetch_add(p, v, __ATOMIC_RELAXED, __HIP_MEMORY_SCOPE_AGENT); }
__device__ __forceinline__ unsigned xb_xcc_id() { return (unsigned)__builtin_amdgcn_s_getreg((3 << 11) | 20) & 0xFu; }
#define XB_SPIN(cond, bar) do { unsigned _sp = 0; while (cond) { __builtin_amdgcn_s_sleep(1); \
    if ((++_sp & 255u) == 0u) { if (xb_ld(&(bar)[XB_TMO])) break; if (_sp > XB_SPIN_CAP) { atomicAdd(&(bar)[XB_TMO], 1u); break; } } } } while (0)
struct XcdBarrier { unsigned* bar; unsigned x; volatile LAS unsigned* st; };
__device__ __forceinline__ XcdBarrier xcd_barrier_post(unsigned* bar, volatile LAS unsigned* st) {
    XcdBarrier b; b.bar = bar; b.x = xb_xcc_id(); b.st = st;
    if (threadIdx.x == 0) (void)xb_add(&bar[XB_XCNT(b.x)], 1u);
    return b;
}
__device__ __forceinline__ void xcd_barrier_complete(unsigned* bar, unsigned x, unsigned& nloc, unsigned& nx) {
    const unsigned G = gridDim.x * gridDim.y * gridDim.z;
    unsigned sum, cnt, mine, sp = 0u;
    for (;;) {
        sum = 0u; cnt = 0u; mine = 0u;
#pragma unroll
        for (unsigned j = 0; j < 16; ++j) { const unsigned c = xb_ld(&bar[XB_XCNT(j)]); sum += c; cnt += (c > 0u) ? 1u : 0u; mine = (j == x) ? c : mine; }
        if (sum == G) break;
        __builtin_amdgcn_s_sleep(1);
        if ((++sp & 255u) == 0u) { if (xb_ld(&bar[XB_TMO])) break; if (sp > XB_SPIN_CAP) { atomicAdd(&bar[XB_TMO], 1u); break; } }
    }
    nloc = mine > 0u ? mine : 1u; nx = cnt > 0u ? cnt : 1u;
}
__device__ __forceinline__ void xcd_barrier(const XcdBarrier& b) {
    asm volatile("s_waitcnt vmcnt(0)" ::: "memory");
    __syncthreads();
    if (threadIdx.x == 0) {
        unsigned* bar = b.bar;
        __builtin_amdgcn_s_waitcnt(0);
        unsigned nloc = b.st[0], nx = b.st[1];
        if (nloc == 0u) { xcd_barrier_complete(bar, b.x, nloc, nx); b.st[0] = nloc; b.st[1] = nx; }
        const unsigned old = xb_add(&bar[XB_XSUB(b.x)], 1u);
        const unsigned gen = old / nloc;
        if (old + 1u == (gen + 1u) * nloc) {
            __builtin_amdgcn_fence(__ATOMIC_RELEASE, "agent");
            asm volatile("s_waitcnt vmcnt(0)" ::: "memory");
            const unsigned og = xb_add(&bar[XB_TOP], 1u);
            const unsigned tg = og / nx;
            if (og + 1u == (tg + 1u) * nx) xb_add(&bar[XB_TOPGEN], 1u);
            else XB_SPIN(xb_ld(&bar[XB_TOPGEN]) == tg, bar);
            __builtin_amdgcn_fence(__ATOMIC_ACQUIRE, "agent");
            xb_add(&bar[XB_XGEN(b.x)], 1u);
            asm volatile("s_waitcnt vmcnt(0)" ::: "memory");
        } else {
            XB_SPIN(xb_ld(&bar[XB_XGEN(b.x)]) == gen, bar);
            __builtin_amdgcn_fence(__ATOMIC_ACQUIRE, "agent");
            asm volatile("s_waitcnt vmcnt(0)" ::: "memory");
        }
    }
    __syncthreads();
}

struct Frame {
    LAS unsigned char* lds;
    int wave, G, vcu;
};
typedef const __attribute__((address_space(4))) Args* KArgs;
#define KARGS(name) KArgs name = (KArgs)__builtin_amdgcn_kernarg_segment_ptr(); asm volatile("" : "+s"(name))


__device__ __forceinline__ int rowmap(int mode, int n, int nhalf) {
    if (mode == 1) { if (n >= 2048) return n; const int d = n & 63, base = n & ~63; const int q = (d & 31) >> 2, j = (d & 3) + ((d >> 5) << 2); return base + 8 * q + j; }
    if (mode == 2) { const int hsel = n >= nhalf ? 1 : 0, nn = n - hsel * nhalf; return 256 * (nn >> 7) + 128 * hsel + (nn & 127); }
    return n;
}
__device__ __forceinline__ void transpose_item(const float* W, int K, int N, bf16_t* WT, int mode, int nhalf, LAS float* scr, int item, int lane) {
    const int nblk = N / 32, kb = item / nblk, nb = item % nblk, k0 = 64 * kb, n0 = 32 * nb;
#pragma unroll 8
    for (int i = 0; i < 32; ++i) { const int kk = 2 * i + (lane >> 5); scr[kk * 33 + (lane & 31)] = W[(size_t)(k0 + kk) * N + n0 + (lane & 31)]; }
    asm volatile("s_waitcnt lgkmcnt(0)" ::: "memory");
    const int c = lane & 7;
#pragma unroll
    for (int j = 0; j < 4; ++j) { const int n = (lane >> 3) + 8 * j; const LAS float* s = scr + (8 * c) * 33 + n;
        u32x4 o; o.x = pk2(s[0 * 33], s[1 * 33]); o.y = pk2(s[2 * 33], s[3 * 33]); o.z = pk2(s[4 * 33], s[5 * 33]); o.w = pk2(s[6 * 33], s[7 * 33]);
        *(u32x4*)(WT + (size_t)rowmap(mode, n0 + n, nhalf) * K + k0 + 8 * c) = o; }
    asm volatile("s_waitcnt lgkmcnt(0)" ::: "memory");
}

__device__ __forceinline__ void prologue(Frame& F) {
    int tid = threadIdx.x; asm volatile("" : "+v"(tid));
    const int lane = tid & 63, wave = F.wave;
    KARGS(ap);
    unsigned char* ws = ap->ws;
    int vcu = F.vcu, G = F.G; OPQ_S(vcu); OPQ_S(G);
#define PIN(k) (ap->in[k])
    {
        LAS float* scr = (LAS float*)(F.lds + wave * 16384);
        const int gw = vcu * 8 + wave, NGW = G * 8;
        constexpr int I_GLU = 16 * 64, I_QKV = 16 * 96, I_WO = 16 * 32, I_WIN = 16 * 176, I_WOUT = 44 * 32;
        constexpr int NITEMS = 2 * I_GLU + 2 * I_QKV + 2 * I_WO + 4 * I_WIN + 4 * I_WOUT;
        for (int it = gw; it < NITEMS; it += NGW) {
            int r = it;
            if (r < 2 * I_GLU) { const int j = r / I_GLU; transpose_item(PIN(14) + (size_t)j * 1024 * 2048, 1024, 2048, (bf16_t*)(ws + WS_WGLU) + (size_t)j * 2048 * 1024, 2, 1024, scr, r % I_GLU, lane); continue; } r -= 2 * I_GLU;
            if (r < 2 * I_QKV) { const int j = r / I_QKV; transpose_item(PIN(15) + (size_t)j * 1024 * 3072, 1024, 3072, (bf16_t*)(ws + WS_WQKV) + (size_t)j * 3072 * 1024, 1, 0, scr, r % I_QKV, lane); continue; } r -= 2 * I_QKV;
            if (r < 2 * I_WO) { const int j = r / I_WO; transpose_item(PIN(16) + (size_t)j * 1024 * 1024, 1024, 1024, (bf16_t*)(ws + WS_WO) + (size_t)j * 1024 * 1024, 0, 0, scr, r % I_WO, lane); continue; } r -= 2 * I_WO;
            if (r < 4 * I_WIN) { const int j = r / I_WIN; transpose_item(PIN(22) + (size_t)j * 1024 * NFF2, 1024, NFF2, (bf16_t*)(ws + WS_WIN) + (size_t)j * NFF2 * 1024, 2, DFF, scr, r % I_WIN, lane); continue; } r -= 4 * I_WIN;
            { const int j = r / I_WOUT; transpose_item(PIN(25) + (size_t)j * DFF * 1024, DFF, 1024, (bf16_t*)(ws + WS_WOUT) + (size_t)j * 1024 * DFF, 0, 0, scr, r % I_WOUT, lane); }
        }
    }
    __syncthreads();
    {
        LAS float* sc = (LAS float*)F.lds;
        LAS float* red = (LAS float*)(F.lds + 32768);
        const float* cin = PIN(1);
        for (int i = tid; i < 8 * 1024; i += NTHR) { const float v = cin[i]; sc[i] = v / (1.0f + expf(-v)); }
        __syncthreads();
        float* mod = (float*)(ws + WS_MOD);
        const int kc = tid >> 6, col = tid & 63;
        for (int it = vcu; it < 4 * 96; it += G) {
            const int li = it / 96, n0 = (it % 96) * 64;
            const float* w = PIN(3) + (size_t)li * 1024 * 6144 + n0 + col;
            float acc[8];
#pragma unroll
            for (int b = 0; b < 8; ++b) acc[b] = 0.f;
#pragma unroll 8
            for (int k = kc * 128; k < kc * 128 + 128; ++k) { const float wv = w[(size_t)k * 6144];
#pragma unroll
                for (int b = 0; b < 8; ++b) acc[b] += sc[b * 1024 + k] * wv; }
#pragma unroll
            for (int b = 0; b < 8; ++b) red[(kc * 8 + b) * 64 + col] = acc[b];
            __syncthreads();
            { const int b = tid >> 6; float s = 0.f;
#pragma unroll
              for (int k2 = 0; k2 < 8; ++k2) s += red[(k2 * 8 + b) * 64 + col];
              mod[((size_t)li * 8 + b) * 6144 + n0 + col] = s + PIN(4)[(size_t)li * 6144 + n0 + col]; }
            __syncthreads();
        }
    }
    __syncthreads();
    {
        const int* pos = (const int*)PIN(2);
        float* cs = (float*)(ws + WS_CS);
        for (int i = vcu * NTHR + tid; i < MTOK * 32; i += G * NTHR) {
            const int m = i >> 5, f = i & 31;
            const double ang = (double)pos[m] * ap->invf[f];
            float s, c; sincos_d(ang, s, c);
            *(f32x2*)(cs + (size_t)i * 2) = (f32x2){c, s};
        }
    }
    if (vcu == 0 && tid < 2) {
        const int j = tid; float d1 = 0.f, d2 = 0.f;
        for (int k = 0; k < 64; ++k) { d1 += PIN(17)[j * 64 + k] * PIN(18)[j * 64 + k]; d2 += PIN(19)[j * 64 + k] * PIN(20)[j * 64 + k]; }
        ((float*)(ws + WS_SCAL))[j] = expf(d1) - expf(d2) + ap->lam_init[j];
    }
    {
        LAS float* Pr = (LAS float*)F.lds;
        LAS float* Pi = Pr + 17 * 64;
        LAS float* Bbr = Pi + 17 * 64;
        LAS float* Bbi = Bbr + 1024;
        LAS float* Ccr = Bbi + 1024;
        LAS float* Cci = Ccr + 1024;
        LAS float* Km = Cci + 1024;
        for (int it = vcu; it < 128; it += G) {
            const int j = it >> 6, g = it & 63;
            __syncthreads();
            if (tid < 64) {
                const int p = tid;
                const double lre = fmin((double)PIN(6)[(j * 64 + g) * 64 + p], -1e-4), lim = (double)PIN(7)[(j * 64 + g) * 64 + p];
                const double dt = exp((double)PIN(8)[j * 64 + g]);
                const double dre = lre * dt, dim_ = lim * dt;
                for (int n = 0; n <= 16; ++n) { float s, c; sincos_d((double)n * dim_, s, c); const double mag = exp((double)n * dre); Pr[n * 64 + p] = (float)(mag * c); Pi[n * 64 + p] = (float)(mag * s); }
                float s1, c1; sincos_d(dim_, s1, c1); const double mag1 = exp(dre);
                const double lbr = mag1 * (double)c1, lbi = mag1 * (double)s1;
                const double nr = expm1(dre) * (double)c1 + ((double)c1 - 1.0);
                const double nr2 = (fabs(dim_) < 0.5) ? (expm1(dre) * (double)c1 - 2.0 * sin(0.5 * dim_) * sin(0.5 * dim_)) : nr;
                const double den = lre * lre + lim * lim;
                const double fre = (nr2 * lre + lbi * lim) / den, fim = (lbi * lre - nr2 * lim) / den;
                (void)lbr;
                for (int c = 0; c < 16; ++c) {
                    const double br = (double)PIN(9)[((size_t)(j * 64 + g) * 64 + p) * 16 + c], bi = (double)PIN(10)[((size_t)(j * 64 + g) * 64 + p) * 16 + c];
                    Bbr[p * 16 + c] = (float)(fre * br - fim * bi); Bbi[p * 16 + c] = (float)(fre * bi + fim * br);
                }
                float* a16 = (float*)(ws + WS_A16) + ((size_t)(j * 64 + g) * 64 + p) * 2;
                a16[0] = Pr[16 * 64 + p]; a16[1] = Pi[16 * 64 + p];
            }
            for (int i = tid; i < 1024; i += NTHR) { Ccr[i] = PIN(11)[(size_t)(j * 64 + g) * 1024 + i]; Cci[i] = PIN(12)[(size_t)(j * 64 + g) * 1024 + i]; }
            __syncthreads();
            for (int i = tid; i < 4096; i += NTHR) {
                const int tau = i >> 8, c = (i >> 4) & 15, c2 = i & 15; float a = 0.f;
                for (int p = 0; p < 64; ++p) {
                    const float cr = Ccr[c * 64 + p], ci = Cci[c * 64 + p], pr = Pr[tau * 64 + p], pi = Pi[tau * 64 + p];
                    const float cpr = cr * pr - ci * pi, cpi = cr * pi + ci * pr;
                    a += cpr * Bbr[p * 16 + c2] - cpi * Bbi[p * 16 + c2];
                }
                Km[i] = a;
            }
            __syncthreads();
            bf16_t* W2 = (bf16_t*)(ws + WS_S5W2) + (size_t)(j * 64 + g) * 256 * 384;
            for (int i = tid; i < 256 * 384; i += NTHR) {
                const int n = i / 384, k = i % 384, t = n >> 4, c = n & 15; float v;
                if (k < 256) { const int s = k >> 4, c2 = k & 15; v = (t >= s) ? Km[((t - s) * 16 + c) * 16 + c2] : 0.f; }
                else { const int q = k - 256, p = q & 63; const float cr = Ccr[c * 64 + p], ci = Cci[c * 64 + p], pr = Pr[(t + 1) * 64 + p], pi = Pi[(t + 1) * 64 + p];
                    v = (q < 64) ? (cr * pr - ci * pi) : -(cr * pi + ci * pr); }
                W2[i] = f2bf(v);
            }
            bf16_t* W1 = (bf16_t*)(ws + WS_S5W1) + (size_t)(j * 64 + g) * 256 * 256;
            for (int i = tid; i < 256 * 256; i += NTHR) {
                const int n = i >> 8, k = i & 255; float v = 0.f;
                if (n < 128) { const int p = n & 63, s = k >> 4, c2 = k & 15; const float pr = Pr[(15 - s) * 64 + p], pi = Pi[(15 - s) * 64 + p], br = Bbr[p * 16 + c2], bi = Bbi[p * 16 + c2];
                    v = (n < 64) ? (pr * br - pi * bi) : (pr * bi + pi * br); }
                W1[i] = f2bf(v);
            }
        }
    }
    __syncthreads();
#undef PIN
}

struct RowP { const float* xsrc; float* xdst; const bf16_t* H; const float* gate; const float* gH; const float* gX; const float* shift; const float* scale; bf16_t* XN; int mode; };
__device__ __forceinline__ void row_phase(Frame& F, const RowP& P) {
    int lane = threadIdx.x & 63; asm volatile("" : "+v"(lane));
    int vcu = F.vcu, G = F.G, wave = F.wave; OPQ_S(vcu); OPQ_S(G); OPQ_S(wave);
    for (int blk = vcu; blk < MTOK / 32; blk += G) {
        const int row0 = blk * 32 + wave * 4;
        const int b = row0 >> 12;
        f32x4 x[4][4]; u32x2 hw[4][4];
#pragma unroll
        for (int r = 0; r < 4; ++r)
#pragma unroll
            for (int j = 0; j < 4; ++j) x[r][j] = __builtin_nontemporal_load((const f32x4*)(P.xsrc + (size_t)(row0 + r) * DM + 4 * lane + 256 * j));
        if (P.H) {
#pragma unroll
            for (int r = 0; r < 4; ++r)
#pragma unroll
                for (int j = 0; j < 4; ++j) hw[r][j] = *(const u32x2*)(P.H + (size_t)(row0 + r) * DM + 4 * lane + 256 * j);
            float rs[4];
#pragma unroll
            for (int r = 0; r < 4; ++r) { float s = 0.f;
#pragma unroll
                for (int j = 0; j < 4; ++j) { const float h0 = bflo(hw[r][j].x), h1 = bfhi(hw[r][j].x), h2 = bflo(hw[r][j].y), h3 = bfhi(hw[r][j].y); s += (h0 * h0 + h1 * h1) + (h2 * h2 + h3 * h3); }
                rs[r] = s; }
#pragma unroll
            for (int o = 1; o < 64; o <<= 1) {
#pragma unroll
                for (int r = 0; r < 4; ++r) rs[r] += shflx_l(rs[r], o, lane); }
#pragma unroll
            for (int r = 0; r < 4; ++r) rs[r] = rsqrtf(rs[r] * (1.0f / DM) + EPS);
#pragma unroll
            for (int j = 0; j < 4; ++j) {
                const f32x4 gt = *(const f32x4*)(P.gate + b * 6144 + 4 * lane + 256 * j), gh = *(const f32x4*)(P.gH + 4 * lane + 256 * j);
                const f32x4 gg = gt * gh;
#pragma unroll
                for (int r = 0; r < 4; ++r) {
                    const f32x4 hv = {bflo(hw[r][j].x), bfhi(hw[r][j].x), bflo(hw[r][j].y), bfhi(hw[r][j].y)};
                    x[r][j] = x[r][j] + gg * (hv * rs[r]);
                    __builtin_nontemporal_store(x[r][j], (f32x4*)(P.xdst + (size_t)(row0 + r) * DM + 4 * lane + 256 * j));
                }
            }
        }
        if (P.mode) {
            float rs[4];
#pragma unroll
            for (int r = 0; r < 4; ++r) { float s = 0.f;
#pragma unroll
                for (int j = 0; j < 4; ++j) s += (x[r][j][0] * x[r][j][0] + x[r][j][1] * x[r][j][1]) + (x[r][j][2] * x[r][j][2] + x[r][j][3] * x[r][j][3]);
                rs[r] = s; }
#pragma unroll
            for (int o = 1; o < 64; o <<= 1) {
#pragma unroll
                for (int r = 0; r < 4; ++r) rs[r] += shflx_l(rs[r], o, lane); }
#pragma unroll
            for (int r = 0; r < 4; ++r) rs[r] = rsqrtf(rs[r] * (1.0f / DM) + EPS);
#pragma unroll
            for (int j = 0; j < 4; ++j) {
                const int d = 4 * lane + 256 * j;
                const f32x4 gx = *(const f32x4*)(P.gX + d), sh = *(const f32x4*)(P.shift + b * 6144 + d), sc = *(const f32x4*)(P.scale + b * 6144 + d);
                const f32x4 gs = gx * (sc + 1.0f);
#pragma unroll
                for (int r = 0; r < 4; ++r) {
                    const int l = (row0 + r) & 4095;
                    const f32x4 v = (x[r][j] * rs[r]) * gs + sh;
                    u32x2 w; w.x = pk2(v[0], v[1]); w.y = pk2(v[2], v[3]);
                    if (P.mode == 1) *(u32x2*)(P.XN + (size_t)(row0 + r) * DM + d) = w;
                    else { const int g = d >> 4, c = d & 15; *(u32x2*)(P.XN + ((size_t)g * 2048 + b * 256 + (l >> 4)) * 384 + (l & 15) * 16 + c) = w; }
                }
            }
        }
    }
}

__device__ __forceinline__ void s5_scan(Frame& F, const float* HL, bf16_t* S5A, const float* A16) {
    int lane = threadIdx.x & 63; asm volatile("" : "+v"(lane));
    int vcu = F.vcu, G = F.G, wave = F.wave; OPQ_S(vcu); OPQ_S(G); OPQ_S(wave);
    for (int wi = wave * G + vcu; wi < 512; wi += 8 * G) {
        const int g = wi >> 3, b = wi & 7;
        const float ar = A16[(g * 64 + lane) * 2], ai = A16[(g * 64 + lane) * 2 + 1];
        float hr = 0.f, hi = 0.f;
        const size_t row0 = (size_t)g * 2048 + b * 256;
#pragma unroll 8
        for (int k = 0; k < 256; ++k) {
            const float lr = HL[(row0 + k) * 128 + lane], li = HL[(row0 + k) * 128 + 64 + lane];
            S5A[(row0 + k) * 384 + 256 + lane] = f2bf(hr); S5A[(row0 + k) * 384 + 320 + lane] = f2bf(hi);
            const float nr = ar * hr - ai * hi + lr, ni = ar * hi + ai * hr + li;
            hr = nr; hi = ni;
        }
    }
}

__device__ __forceinline__ void conv_fixup(Frame& F, const float* halo, bf16_t* Gout, const float* cw, const float* cb) {
    constexpr int NQ = DFF / 4;
    int tid0 = threadIdx.x; asm volatile("" : "+v"(tid0));
    int vcu = F.vcu, G = F.G; OPQ_S(vcu); OPQ_S(G);
    for (int i = vcu * NTHR + tid0; i < 512 * 2 * NQ; i += G * NTHR) {
        const int cq = i % NQ, rj = i / NQ, j = rj & 1, s = rj >> 1;
        const int ca = cq * 4, cbc = DFF + ca;
        const bool first = (s & 63) == 0;
        const float* h0 = halo + (size_t)s * 4 * NFF2; const float* hm = halo + (size_t)(s - 1) * 4 * NFF2;
        const f32x4 z = {0.f, 0.f, 0.f, 0.f};
        f32x4 a0, a1, a2, b0, b1, b2;
        if (j == 0) { a0 = *(const f32x4*)(h0 + ca); b0 = *(const f32x4*)(h0 + cbc);
            a1 = first ? z : *(const f32x4*)(hm + 3 * NFF2 + ca); b1 = first ? z : *(const f32x4*)(hm + 3 * NFF2 + cbc);
            a2 = first ? z : *(const f32x4*)(hm + 2 * NFF2 + ca); b2 = first ? z : *(const f32x4*)(hm + 2 * NFF2 + cbc); }
        else { a0 = *(const f32x4*)(h0 + NFF2 + ca); b0 = *(const f32x4*)(h0 + NFF2 + cbc);
            a1 = *(const f32x4*)(h0 + ca); b1 = *(const f32x4*)(h0 + cbc);
            a2 = first ? z : *(const f32x4*)(hm + 3 * NFF2 + ca); b2 = first ? z : *(const f32x4*)(hm + 3 * NFF2 + cbc); }
        const f32x4 w0a = *(const f32x4*)(cw + ca), w1a = *(const f32x4*)(cw + NFF2 + ca), w2a = *(const f32x4*)(cw + 2 * NFF2 + ca), ba = *(const f32x4*)(cb + ca);
        const f32x4 w0b = *(const f32x4*)(cw + cbc), w1b = *(const f32x4*)(cw + NFF2 + cbc), w2b = *(const f32x4*)(cw + 2 * NFF2 + cbc), bb = *(const f32x4*)(cb + cbc);
        float o[4];
#pragma unroll
        for (int e = 0; e < 4; ++e) { const float ua = ba[e] + w2a[e] * a0[e] + w1a[e] * a1[e] + w0a[e] * a2[e]; const float ub = bb[e] + w2b[e] * b0[e] + w1b[e] * b1[e] + w0b[e] * b2[e]; o[e] = gelu_tanh(ua) * ub; }
        u32x2 w; w.x = pk2(o[0], o[1]); w.y = pk2(o[2], o[3]);
        *(u32x2*)(Gout + (size_t)(64 * s + j) * DFF + ca) = w;
    }
}

#ifndef REP_PRO
#define REP_PRO 1
#endif
#ifndef REP_S5
#define REP_S5 1
#endif
#ifndef REP_QKV
#define REP_QKV 1
#endif
#ifndef REP_ATT
#define REP_ATT 1
#endif
#ifndef REP_WO
#define REP_WO 1
#endif
#ifndef REP_FFN
#define REP_FFN 1
#endif
__global__ void __launch_bounds__(NTHR, 2) mega_fwd(Args args) {
    extern __shared__ __attribute__((aligned(16))) unsigned char lds_raw[];
    cg::grid_group grid = cg::this_grid();
    Frame F;
    F.lds = (LAS unsigned char*)lds_raw;
    F.wave = __builtin_amdgcn_readfirstlane((int)threadIdx.x >> 6);
    F.G = gridDim.x; { const int bx = blockIdx.x; F.vcu = (F.G % 8 == 0) ? (bx % 8) * (F.G / 8) + bx / 8 : bx; }
    volatile LAS unsigned* bst = (volatile LAS unsigned*)(F.lds + 131072 + 256);
    if (threadIdx.x < 2) bst[threadIdx.x] = 0u;
    __syncthreads();
    const XcdBarrier xbar = xcd_barrier_post((unsigned*)args.ws, bst);
#define GSYNC() xcd_barrier(xbar)

    for (int rep = 0; rep < REP_PRO; ++rep) { prologue(F); grid.sync(); }

#pragma unroll 1
    for (int li_ = 0; li_ <= DEPTH; ++li_) {
        {
            KARGS(ap); int li = li_; OPQ_S(li);
            unsigned char* ws = ap->ws; const float* mod = (const float*)(ws + WS_MOD); const float* ng = ap->in[5];
            const bool s5 = (li & 1) == 0;
            const float* modl = mod + (size_t)li * 8 * 6144;
            RowP P;
            P.xsrc = (li == 0) ? ap->in[0] : ap->out; P.xdst = ap->out;
            P.H = (li == 0) ? nullptr : (const bf16_t*)(ws + WS_H); P.gate = (li == 0) ? nullptr : (mod + (size_t)(li - 1) * 8 * 6144 + 5 * 1024); P.gH = (li == 0) ? nullptr : (ng + ((li - 1) * 4 + 3) * 1024);
            P.gX = ng + (li * 4 + 0) * 1024; P.shift = modl; P.scale = modl + 1024;
            P.XN = s5 ? (bf16_t*)(ws + WS_SCR + SCR_S5A) : (bf16_t*)(ws + WS_XN); P.mode = (li == DEPTH) ? 0 : (s5 ? 2 : 1);
            row_phase(F, P);
        }
        if (li_ == DEPTH) break;
        GSYNC();
        if ((li_ & 1) == 0) {
          for (int rep = 0; rep < REP_S5; ++rep) {
            {
                KARGS(ap); int j = li_ >> 1; OPQ_S(j); unsigned char* ws = ap->ws;
                pg8::Gemm g{(const bf16_t*)(ws + WS_SCR + SCR_S5A), (const bf16_t*)(ws + WS_S5W1) + (size_t)j * 64 * 256 * 256, 384, 256, 256}; pg8::S5Order S{opqi(F.G), opqi((int)blockIdx.x)}; pg8::EpiHL E{(float*)(ws + WS_SCR + SCR_HL)};
                pg8::gemm_phase(F.lds, g, S, E);
            }
            GSYNC();
            {
                KARGS(ap); int j = li_ >> 1; OPQ_S(j); unsigned char* ws = ap->ws;
                s5_scan(F, (const float*)(ws + WS_SCR + SCR_HL), (bf16_t*)(ws + WS_SCR + SCR_S5A), (const float*)(ws + WS_A16) + (size_t)j * 64 * 64 * 2);
            }
            GSYNC();
            {
                KARGS(ap); int j = li_ >> 1; OPQ_S(j); unsigned char* ws = ap->ws;
                pg8::Gemm g{(const bf16_t*)(ws + WS_SCR + SCR_S5A), (const bf16_t*)(ws + WS_S5W2) + (size_t)j * 64 * 256 * 384, 384, 384, 384}; pg8::S5Order S{opqi(F.G), opqi((int)blockIdx.x)};
                pg8::EpiS5Y E{(const bf16_t*)(ws + WS_SCR + SCR_S5A), (bf16_t*)(ws + WS_SCR + SCR_Z), ap->in[13] + j * 1024};
                pg8::gemm_phase(F.lds, g, S, E);
            }
            GSYNC();
            {
                KARGS(ap); int j = li_ >> 1; OPQ_S(j); unsigned char* ws = ap->ws;
                pg8::Gemm g{(const bf16_t*)(ws + WS_SCR + SCR_Z), (const bf16_t*)(ws + WS_WGLU) + (size_t)j * 2048 * 1024, 1024, 1024, 1024}; pg8::StaticOrder S; S.init(MTOK, 2048, opqi(F.G), opqi((int)blockIdx.x)); pg8::EpiGLU E{(bf16_t*)(ws + WS_H)};
                pg8::gemm_phase(F.lds, g, S, E);
            }
            GSYNC();
          }
        } else {
          for (int rep = 0; rep < REP_QKV; ++rep) {
            {
                KARGS(ap); int j = li_ >> 1; OPQ_S(j); unsigned char* ws = ap->ws;
                const bf16_t* Wqkv = (const bf16_t*)(ws + WS_WQKV) + (size_t)j * 3072 * 1024;
                pg8::Gemm g{(const bf16_t*)(ws + WS_XN), Wqkv, 1024, 1024, 1024}; pg8::StaticOrder S; S.init(MTOK, 2048, opqi(F.G), opqi((int)blockIdx.x));
                pg8::EpiQK E{(bf16_t*)(ws + WS_SCR + SCR_Q), (bf16_t*)(ws + WS_SCR + SCR_K), (const float*)(ws + WS_CS), 0.125f * 1.4426950408889634f};
                pg8::gemm_phase(F.lds, g, S, E);
            }
            {
                KARGS(ap); int j = li_ >> 1; OPQ_S(j); unsigned char* ws = ap->ws;
                const bf16_t* Wqkv = (const bf16_t*)(ws + WS_WQKV) + (size_t)j * 3072 * 1024;
                pg8::Gemm g{Wqkv + (size_t)2048 * 1024, (const bf16_t*)(ws + WS_XN), 1024, 1024, 1024}; pg8::StaticOrder S; S.init(1024, MTOK, opqi(F.G), opqi((int)blockIdx.x)); pg8::EpiVt E{(bf16_t*)(ws + WS_SCR + SCR_VT)};
                pg8::gemm_phase(F.lds, g, S, E);
            }
            GSYNC();
          }
          for (int rep = 0; rep < REP_ATT; ++rep) {
            {
                KARGS(ap); int j = li_ >> 1; OPQ_S(j); unsigned char* ws = ap->ws;
                bf16_t* Qb = (bf16_t*)(ws + WS_SCR + SCR_Q);
                attn_phase(F.lds, Qb, (const bf16_t*)(ws + WS_SCR + SCR_K), (const bf16_t*)(ws + WS_SCR + SCR_VT), (bf16_t*)(ws + WS_XN), ap->in[21] + j * 128, ((const float*)(ws + WS_SCAL))[j], 1.0f - ap->lam_init[j], F.G, F.vcu);
            }
            GSYNC();
          }
          for (int rep = 0; rep < REP_WO; ++rep) {
            {
                KARGS(ap); int j = li_ >> 1; OPQ_S(j); unsigned char* ws = ap->ws;
                pg8::Gemm g{(const bf16_t*)(ws + WS_XN), (const bf16_t*)(ws + WS_WO) + (size_t)j * 1024 * 1024, 1024, 1024, 1024}; pg8::StaticOrder S; S.init(MTOK, 1024, opqi(F.G), opqi((int)blockIdx.x)); pg8::EpiPlain E{(bf16_t*)(ws + WS_H), 1024};
                pg8::gemm_phase(F.lds, g, S, E);
            }
            GSYNC();
          }
        }
        {
            KARGS(ap); int li = li_; OPQ_S(li);
            unsigned char* ws = ap->ws; const float* mod = (const float*)(ws + WS_MOD); const float* ng = ap->in[5];
            const float* modl = mod + (size_t)li * 8 * 6144;
            RowP P;
            P.xsrc = (li == 0) ? ap->in[0] : ap->out; P.xdst = ap->out;
            P.H = (const bf16_t*)(ws + WS_H); P.gate = modl + 2 * 1024; P.gH = ng + (li * 4 + 1) * 1024;
            P.gX = ng + (li * 4 + 2) * 1024; P.shift = modl + 3 * 1024; P.scale = modl + 4 * 1024;
            P.XN = (bf16_t*)(ws + WS_XN); P.mode = 1;
            row_phase(F, P);
        }
        GSYNC();
        for (int rep = 0; rep < REP_FFN; ++rep) {
        {
            KARGS(ap); int li = li_; OPQ_S(li); unsigned char* ws = ap->ws;
            pg8::Gemm g{(const bf16_t*)(ws + WS_XN), (const bf16_t*)(ws + WS_WIN) + (size_t)li * NFF2 * 1024, 1024, 1024, 1024}; pg8::StaticOrder S; S.init(MTOK, NFF2, opqi(F.G), opqi((int)blockIdx.x));
            pg8::EpiWin E{(bf16_t*)(ws + WS_SCR + SCR_G), (float*)(ws + WS_SCR + SCR_HALO), ap->in[23] + (size_t)li * 3 * NFF2, ap->in[24] + (size_t)li * NFF2};
            pg8::gemm_phase(F.lds, g, S, E);
        }
        GSYNC();
        {
            KARGS(ap); int li = li_; OPQ_S(li); unsigned char* ws = ap->ws;
            conv_fixup(F, (const float*)(ws + WS_SCR + SCR_HALO), (bf16_t*)(ws + WS_SCR + SCR_G), ap->in[23] + (size_t)li * 3 * NFF2, ap->in[24] + (size_t)li * NFF2);
        }
        GSYNC();
        {
            KARGS(ap); int li = li_; OPQ_S(li); unsigned char* ws = ap->ws;
            pg8::Gemm g{(const bf16_t*)(ws + WS_SCR + SCR_G), (const bf16_t*)(ws + WS_WOUT) + (size_t)li * 1024 * DFF, DFF, DFF, DFF}; pg8::StaticOrder S; S.init(MTOK, 1024, opqi(F.G), opqi((int)blockIdx.x)); pg8::EpiPlain E{(bf16_t*)(ws + WS_H), 1024};
            pg8::gemm_phase(F.lds, g, S, E);
        }
        GSYNC();
        }
    }
}

extern "C" void kernel_launch(void* const* d_in, const int* in_sizes, int n_in, void* d_out, int out_size, void* d_ws, size_t ws_size, hipStream_t stream) {
    static int grid = 0;
    if (grid == 0) {
        if (n_in != 26 || out_size != MTOK * DM || ws_size < WS_END) { fprintf(stderr, "kernel_launch: unexpected shapes (n_in %d out %d ws %zu need %zu)\n", n_in, out_size, ws_size, (size_t)WS_END); grid = -1; return; }
        int dev = 0, cus = 0, per_cu = 0;
        hipGetDevice(&dev);
        hipDeviceGetAttribute(&cus, hipDeviceAttributeMultiprocessorCount, dev);
        if (hipFuncSetAttribute((const void*)mega_fwd, hipFuncAttributeMaxDynamicSharedMemorySize, LDS_BYTES) != hipSuccess) { fprintf(stderr, "kernel_launch: hipFuncSetAttribute failed\n"); grid = -1; return; }
        if (hipOccupancyMaxActiveBlocksPerMultiprocessor(&per_cu, (const void*)mega_fwd, NTHR, LDS_BYTES) != hipSuccess || per_cu < 1) { fprintf(stderr, "kernel_launch: occupancy query failed (%d)\n", per_cu); per_cu = 1; }
        (void)hipGetLastError();
        grid = cus * per_cu;
    }
    if (grid < 0) return;
    Args a{};
    for (int i = 0; i < 26; ++i) a.in[i] = (const float*)d_in[i];
    a.out = (float*)d_out; a.ws = (unsigned char*)d_ws;
    for (int f = 0; f < 32; ++f) a.invf[f] = pow(10000.0, -(double)f / 32.0);
    a.lam_init[0] = (float)(0.8 - 0.6 * exp(-0.3 * 1.0));
    a.lam_init[1] = (float)(0.8 - 0.6 * exp(-0.3 * 3.0));
    if (hipMemsetAsync(d_ws, 0, 16384, stream) != hipSuccess) { fprintf(stderr, "kernel_launch: memset of barrier words failed\n"); return; }
    void* kargs[] = {&a};
    hipError_t e = hipLaunchCooperativeKernel((const void*)mega_fwd, dim3(grid), dim3(NTHR), kargs, LDS_BYTES, stream);
    if (e != hipSuccess) fprintf(stderr, "cooperative launch failed: %s (grid %d)\n", hipGetErrorString(e), grid);
}
```
